# Optimizing an MI355X kernel written in HIP

```python
import math
import jax, jax.numpy as jnp
from jax import lax
import numpy as np

D_MODEL = 2048
BATCH = 4
SEQ = 8192
DEPTH = 2

SC_W = 512
SC_CONV = 3
SSM_W = 512
SSM_GROUP = 16
SSM_GROUPS = SSM_W // SSM_GROUP
SSM_STATE = 64
N_Q_HEADS = 16
N_KV_HEADS = 4
HEAD_DIM = 64
ATT_W = N_Q_HEADS * HEAD_DIM
KV_W = N_KV_HEADS * HEAD_DIM
ROT_DIM = HEAD_DIM // 4
ROPE_THETA = 500000.0
N_IDX_HEADS = 8
IDX_DIM = 64
TOPK_MAX = 256
BLOCK_Q = 128
N_BRANCH = 3
D_FF = 5632
FFN_CONV = 3
NORM_EPS = 1e-6

SPLIT_SIZES = (SC_W, SC_W, SC_W, SSM_W, ATT_W, KV_W, KV_W,
               N_IDX_HEADS * IDX_DIM, IDX_DIM, N_IDX_HEADS,
               D_MODEL, D_MODEL, D_MODEL)
N_IN = sum(SPLIT_SIZES)

kernel_name = "hybrid_conv_s5_dsa_block"


def rms_norm(x, g):
    xf = x.astype(jnp.float32)
    y = xf * lax.rsqrt(jnp.mean(xf * xf, axis=-1, keepdims=True) + NORM_EPS)
    return (y * g.astype(jnp.float32)).astype(x.dtype)


def causal_dwconv(x, w):
    width = w.shape[0]
    seq = x.shape[1]
    w = w.astype(x.dtype)
    xp = jnp.pad(x, ((0, 0), (width - 1, 0), (0, 0)))
    out = w[width - 1] * x
    for j in range(width - 1):
        out = out + w[j] * xp[:, j:j + seq]
    return out


def rope_tables(positions):
    inv_freq = ROPE_THETA ** (-jnp.arange(0, ROT_DIM, 2, dtype=jnp.float32) / ROT_DIM)
    ang = positions.astype(jnp.float32)[..., None] * inv_freq
    return jnp.cos(ang)[:, :, None, :], jnp.sin(ang)[:, :, None, :]


def partial_rope(x, cos, sin):
    half = ROT_DIM // 2
    x1 = x[..., :half].astype(jnp.float32)
    x2 = x[..., half:ROT_DIM].astype(jnp.float32)
    rot = jnp.concatenate([x1 * cos - x2 * sin, x2 * cos + x1 * sin], axis=-1).astype(x.dtype)
    return jnp.concatenate([rot, x[..., ROT_DIM:]], axis=-1)


def _ssm_combine(left, right):
    a_l, b_l = left
    a_r, b_r = right
    return a_l * a_r, a_r * b_l + b_r


def s5_mixer(u, a_re, a_im, log_dt, b_re, b_im, c_re, c_im, d_skip, w_glu):
    bsz, seq, _ = u.shape
    uf = u.astype(jnp.float32).reshape(bsz, seq, SSM_GROUPS, SSM_GROUP)
    a = lax.complex(a_re.astype(jnp.float32), a_im.astype(jnp.float32))
    dt = jnp.exp(log_dt.astype(jnp.float32))[:, None]
    a_bar = jnp.exp(dt * a)
    b_bar = ((a_bar - 1.0) / a)[..., None] * lax.complex(
        b_re.astype(jnp.float32), b_im.astype(jnp.float32))
    bu = jnp.einsum('bsgp,gnp->bsgn', uf.astype(jnp.complex64), b_bar)
    a_seq = jnp.broadcast_to(a_bar, (1, seq) + a_bar.shape)
    _, state = lax.associative_scan(_ssm_combine, (a_seq, bu), axis=1)
    c = lax.complex(c_re.astype(jnp.float32), c_im.astype(jnp.float32))
    y = jnp.real(jnp.einsum('bsgn,gpn->bsgp', state, c)) \
        + d_skip.astype(jnp.float32).reshape(SSM_GROUPS, SSM_GROUP) * uf
    z = jax.nn.gelu(y.reshape(bsz, seq, SSM_W))
    z = z * jax.nn.sigmoid(z @ w_glu.astype(jnp.float32))
    return z.astype(u.dtype)


def dsa_attention(q, k, v, qi, ki, wi):
    bsz, seq = q.shape[0], q.shape[1]
    k_sel = min(TOPK_MAX, seq // 4)
    n_blk = seq // BLOCK_Q
    rep = N_Q_HEADS // N_KV_HEADS

    def to_blocks(t):
        return jnp.swapaxes(t.reshape((bsz, n_blk, BLOCK_Q) + t.shape[2:]), 0, 1)

    qb = to_blocks(q.reshape(bsz, seq, N_KV_HEADS, rep, HEAD_DIM))
    qib = to_blocks(qi)
    wib = to_blocks(wi)
    t0s = jnp.arange(n_blk, dtype=jnp.int32) * BLOCK_Q
    key_pos = jnp.arange(seq, dtype=jnp.int32)
    bidx = jnp.arange(bsz)[:, None, None]

    def one_block(args):
        q_b, qi_b, wi_b, t0 = args
        t = t0 + jnp.arange(BLOCK_Q, dtype=jnp.int32)
        dots = jnp.einsum('bqhd,bsd->bqhs', qi_b, ki).astype(jnp.float32) * (IDX_DIM ** -0.5)
        iscore = jnp.einsum('bqhs,bqh->bqs', jax.nn.relu(dots),
                            wi_b.astype(jnp.float32) * (N_IDX_HEADS ** -0.5))
        causal = key_pos[None, :] <= t[:, None]
        iscore = jnp.where(causal[None], iscore, -jnp.inf)
        _, idx = lax.top_k(iscore, k_sel)
        valid = idx <= t[None, :, None]
        kg = k[bidx, idx]
        vg = v[bidx, idx]
        logits = jnp.einsum('bqgrd,bqkgd->bqgrk', q_b, kg).astype(jnp.float32) * (HEAD_DIM ** -0.5)
        logits = jnp.where(valid[:, :, None, None, :], logits, -jnp.inf)
        p = jax.nn.softmax(logits, axis=-1).astype(vg.dtype)
        return jnp.einsum('bqgrk,bqkgd->bqgrd', p, vg)

    ob = lax.map(one_block, (qb, qib, wib, t0s))
    return jnp.swapaxes(ob, 0, 1).reshape(bsz, seq, ATT_W)


def hybrid_mixer(h, cos, sin, w_in, sc_conv, ssm_a_re, ssm_a_im, ssm_log_dt, ssm_b_re, ssm_b_im,
                 ssm_c_re, ssm_c_im, ssm_d, ssm_glu, w_branch_a, w_branch_b, w_branch_c, w_out):
    bsz, seq, _ = h.shape
    offsets = []
    acc = 0
    for s in SPLIT_SIZES[:-1]:
        acc += s
        offsets.append(acc)
    (sc_x, sc_b, sc_c, ssm_u, q, k, v, qi, ki, wi,
     g_a, g_b, g_c) = jnp.split(h @ w_in, offsets, axis=-1)

    y_a = sc_b * causal_dwconv(sc_c * sc_x, sc_conv)
    y_b = s5_mixer(ssm_u, ssm_a_re, ssm_a_im, ssm_log_dt, ssm_b_re, ssm_b_im,
                   ssm_c_re, ssm_c_im, ssm_d, ssm_glu)
    q = partial_rope(q.reshape(bsz, seq, N_Q_HEADS, HEAD_DIM), cos, sin)
    k = partial_rope(k.reshape(bsz, seq, N_KV_HEADS, HEAD_DIM), cos, sin)
    v = v.reshape(bsz, seq, N_KV_HEADS, HEAD_DIM)
    qi = partial_rope(qi.reshape(bsz, seq, N_IDX_HEADS, IDX_DIM), cos, sin)
    ki = partial_rope(ki[:, :, None, :], cos, sin)[:, :, 0, :]
    y_c = dsa_attention(q, k, v, qi, ki, wi)

    merged = (jax.nn.sigmoid(g_a) * (y_a @ w_branch_a)
              + jax.nn.sigmoid(g_b) * (y_b @ w_branch_b)
              + jax.nn.sigmoid(g_c) * (y_c @ w_branch_c))
    return merged @ w_out


def conv_glu_ffn(h, w_up, conv_w, w_down):
    up = causal_dwconv(h @ w_up, conv_w)
    g, u = jnp.split(up, 2, axis=-1)
    return (jax.nn.silu(g) * u) @ w_down


def setup_inputs(seed: int = 0) -> dict:
    key = jax.random.key(seed)
    ks = jax.random.split(key, 24)
    f32 = jnp.float32

    def nrm(k, shape, scale):
        return jax.random.normal(k, shape, f32) * scale

    x = jax.random.normal(ks[0], (BATCH, SEQ, D_MODEL), f32)
    positions = jnp.broadcast_to(jnp.arange(SEQ, dtype=jnp.int32), (BATCH, SEQ))
    norm_mix = 1.0 + nrm(ks[1], (DEPTH, D_MODEL), 0.02)
    w_in = nrm(ks[2], (DEPTH, D_MODEL, N_IN), D_MODEL ** -0.5)
    sc_conv = nrm(ks[3], (DEPTH, SC_CONV, SC_W), SC_CONV ** -0.5)
    ssm_a_re = -0.5 + nrm(ks[4], (DEPTH, SSM_GROUPS, SSM_STATE), 0.01)
    ssm_a_im = math.pi * jnp.arange(SSM_STATE, dtype=f32) + nrm(ks[5], (DEPTH, SSM_GROUPS, SSM_STATE), 0.01)
    ssm_log_dt = jax.random.uniform(ks[6], (DEPTH, SSM_GROUPS), f32, math.log(1e-3), math.log(1e-1))
    b_scale = (2.0 * SSM_GROUP) ** -0.5
    c_scale = (2.0 * SSM_STATE) ** -0.5
    ssm_b_re = nrm(ks[7], (DEPTH, SSM_GROUPS, SSM_STATE, SSM_GROUP), b_scale)
    ssm_b_im = nrm(ks[8], (DEPTH, SSM_GROUPS, SSM_STATE, SSM_GROUP), b_scale)
    ssm_c_re = nrm(ks[9], (DEPTH, SSM_GROUPS, SSM_GROUP, SSM_STATE), c_scale)
    ssm_c_im = nrm(ks[10], (DEPTH, SSM_GROUPS, SSM_GROUP, SSM_STATE), c_scale)
    ssm_d = nrm(ks[11], (DEPTH, SSM_W), 1.0)
    ssm_glu = nrm(ks[12], (DEPTH, SSM_W, SSM_W), SSM_W ** -0.5)
    w_branch_a = nrm(ks[13], (DEPTH, SC_W, D_MODEL), SC_W ** -0.5)
    w_branch_b = nrm(ks[14], (DEPTH, SSM_W, D_MODEL), SSM_W ** -0.5)
    w_branch_c = nrm(ks[15], (DEPTH, ATT_W, D_MODEL), ATT_W ** -0.5)
    w_out = nrm(ks[16], (DEPTH, D_MODEL, D_MODEL), D_MODEL ** -0.5)
    norm_ffn = 1.0 + nrm(ks[17], (DEPTH, D_MODEL), 0.02)
    w_up = nrm(ks[18], (DEPTH, D_MODEL, 2 * D_FF), D_MODEL ** -0.5)
    ffn_conv = nrm(ks[19], (DEPTH, FFN_CONV, 2 * D_FF), FFN_CONV ** -0.5)
    w_down = nrm(ks[20], (DEPTH, D_FF, D_MODEL), D_FF ** -0.5)
    norm_final = 1.0 + nrm(ks[21], (D_MODEL,), 0.02)
    return {"x": x, "positions": positions, "norm_mix": norm_mix, "w_in": w_in,
            "sc_conv": sc_conv, "ssm_a_re": ssm_a_re, "ssm_a_im": ssm_a_im,
            "ssm_log_dt": ssm_log_dt, "ssm_b_re": ssm_b_re, "ssm_b_im": ssm_b_im,
            "ssm_c_re": ssm_c_re, "ssm_c_im": ssm_c_im, "ssm_d": ssm_d, "ssm_glu": ssm_glu,
            "w_branch_a": w_branch_a, "w_branch_b": w_branch_b, "w_branch_c": w_branch_c,
            "w_out": w_out, "norm_ffn": norm_ffn, "w_up": w_up, "ffn_conv": ffn_conv,
            "w_down": w_down, "norm_final": norm_final}


def reference(x, positions, norm_mix, w_in, sc_conv, ssm_a_re, ssm_a_im, ssm_log_dt,
              ssm_b_re, ssm_b_im, ssm_c_re, ssm_c_im, ssm_d, ssm_glu, w_branch_a,
              w_branch_b, w_branch_c, w_out, norm_ffn, w_up, ffn_conv, w_down, norm_final):
    cos, sin = rope_tables(positions)
    for l in range(DEPTH):
        h = rms_norm(x, norm_mix[l])
        x = x + hybrid_mixer(h, cos, sin, w_in[l], sc_conv[l], ssm_a_re[l], ssm_a_im[l],
                             ssm_log_dt[l], ssm_b_re[l], ssm_b_im[l], ssm_c_re[l], ssm_c_im[l],
                             ssm_d[l], ssm_glu[l], w_branch_a[l], w_branch_b[l], w_branch_c[l],
                             w_out[l])
        h = rms_norm(x, norm_ffn[l])
        x = x + conv_glu_ffn(h, w_up[l], ffn_conv[l], w_down[l])
    return rms_norm(x, norm_final)
```

```cpp
#include <hip/hip_runtime.h>
#include <hip/hip_cooperative_groups.h>
#include <cstdio>
namespace cg = cooperative_groups;

#define DEV __device__ __forceinline__
#define LAS __attribute__((address_space(3)))
typedef unsigned short bf16_t;
typedef short bf16x8 __attribute__((ext_vector_type(8)));
typedef float f32x4 __attribute__((ext_vector_type(4)));
typedef float f32x16 __attribute__((ext_vector_type(16)));
typedef unsigned u32x4 __attribute__((ext_vector_type(4)));
typedef unsigned u32x2 __attribute__((ext_vector_type(2)));

constexpr int D = 2048, NB = 4, S = 8192, NIN = 10312, NINP = 10496, DFF = 5632, DFF2 = 11264;
constexpr int C_SCX = 0, C_SCB = 512, C_SCC = 1024, C_SSMU = 1536, C_Q = 2048, C_K = 3072, C_V = 3328, C_QI = 3584, C_KI = 4096, C_WI = 4160,
              C_GA = 4168, C_GB = 6216, C_GC = 8264;
constexpr int LDS_BYTES = 131072;

constexpr size_t WL_WIN = 0;
constexpr size_t WL_WA = WL_WIN + (size_t)NINP * D * 2;
constexpr size_t WL_WB = WL_WA + (size_t)D * 512 * 2;
constexpr size_t WL_WC = WL_WB + (size_t)D * 512 * 2;
constexpr size_t WL_WGLU = WL_WC + (size_t)D * 1024 * 2;
constexpr size_t WL_WOUT = WL_WGLU + (size_t)512 * 512 * 2;
constexpr size_t WL_WUP = WL_WOUT + (size_t)D * D * 2;
constexpr size_t WL_WDOWN = WL_WUP + (size_t)DFF2 * D * 2;
constexpr size_t WL_SIZE = WL_WDOWN + (size_t)D * DFF * 2;
constexpr size_t WS_W = 0;
constexpr size_t WS_CT = WS_W + 2 * WL_SIZE;
constexpr size_t WS_ST = WS_CT + (size_t)NB * S * 8 * 4;
constexpr size_t WS_H = WS_ST + (size_t)NB * S * 8 * 4;
constexpr size_t WS_P = WS_H + (size_t)S * D * 2;
constexpr size_t WS_YA = WS_P + (size_t)S * NINP * 2;
constexpr size_t WS_YB = WS_YA + (size_t)S * 512 * 2;
constexpr size_t WS_Z = WS_YB + (size_t)S * 512 * 2;
constexpr size_t WS_YC = WS_Z + (size_t)S * 512 * 2;
constexpr size_t WS_MB = WS_YC + (size_t)S * 1024 * 2;
constexpr size_t WS_IDX = WS_MB + (size_t)S * D * 2;
constexpr size_t WS_XEND = WS_IDX + (size_t)S * 256 * 4;
constexpr size_t WS_BIG = WS_XEND + (size_t)32 * 64 * 64 * 2 * 4;
constexpr size_t WS_UP = WS_BIG;
constexpr size_t WS_ACT = WS_UP + (size_t)S * DFF2 * 2;
constexpr size_t WS_SC = WS_BIG;
constexpr size_t WS_MF = WS_BIG;
constexpr size_t WS_END = WS_ACT + (size_t)S * DFF * 2;
static_assert(WS_SC + (size_t)2048 * 4 * 8192 * 4 <= WS_END, "score scratch must fit the aliased region");

struct Params {
    const float* in[23];
    float* out;
    unsigned char* ws;
    float inv_freq[8];
};

DEV unsigned cvt_pk_bf16(float lo, float hi) { unsigned r; asm volatile("v_cvt_pk_bf16_f32 %0, %1, %2" : "=v"(r) : "v"(lo), "v"(hi)); return r; }
DEV float bf_lo(unsigned u) { return __uint_as_float(u << 16); }
DEV float bf_hi(unsigned u) { return __uint_as_float(u & 0xffff0000u); }
DEV void unpack8(const u32x4 v, float (&f)[8]) {
#pragma unroll
    for (int i = 0; i < 4; ++i) { f[2 * i] = bf_lo(v[i]); f[2 * i + 1] = bf_hi(v[i]); }
}
DEV u32x4 pack8(const float (&f)[8]) { u32x4 r; r[0] = cvt_pk_bf16(f[0], f[1]); r[1] = cvt_pk_bf16(f[2], f[3]); r[2] = cvt_pk_bf16(f[4], f[5]); r[3] = cvt_pk_bf16(f[6], f[7]); return r; }
DEV float wave_sum_f(float v) {
#pragma unroll
    for (int o = 32; o; o >>= 1) v += __shfl_xor(v, o);
    return v;
}
DEV int wave_sum_i(int v) {
#pragma unroll
    for (int o = 32; o; o >>= 1) v += __shfl_xor(v, o);
    return v;
}
DEV float wave_max_f(float v) {
#pragma unroll
    for (int o = 32; o; o >>= 1) v = fmaxf(v, __shfl_xor(v, o));
    return v;
}
DEV float sigmoidf_(float x) { return 1.f / (1.f + __expf(-x)); }
DEV float gelu_tanh(float x) { const float u = 0.7978845608028654f * (x + 0.044715f * x * x * x); const float t = 1.f - 2.f / (1.f + __expf(2.f * u)); return 0.5f * x * (1.f + t); }
DEV void sincos_acc(float x, float& s, float& c) {
    const float k = rintf(x * 0.636619772367581343f);
    float y = fmaf(k, -1.57073974609375f, x); y = fmaf(k, -5.657970905303955078125e-05f, y); y = fmaf(k, -9.920936294705029468e-10f, y);
    const int q = ((int)k) & 3; const float y2 = y * y;
    const float sf = y + y * y2 * (-1.6666667163e-01f + y2 * (8.3333337680e-03f + y2 * (-1.9841270114e-04f + y2 * 2.7557314297e-06f)));
    const float cf = 1.f + y2 * (-0.5f + y2 * (4.1666667908e-02f + y2 * (-1.3888889225e-03f + y2 * (2.4801587642e-05f + y2 * (-2.7557314297e-07f)))));
    s = (q == 0) ? sf : (q == 1) ? cf : (q == 2) ? -sf : -cf;
    c = (q == 0) ? cf : (q == 1) ? -sf : (q == 2) ? -cf : sf;
}
DEV int opaque_tid(int wv) { int t; asm volatile("v_mbcnt_lo_u32_b32 %0, -1, 0\n\tv_mbcnt_hi_u32_b32 %0, -1, %0" : "=v"(t)); return (wv << 6) + t; }
DEV void wave_mem_sync() { __builtin_amdgcn_fence(__ATOMIC_SEQ_CST, "workgroup"); __builtin_amdgcn_wave_barrier(); }

namespace pg8 {
constexpr int BM = 256, BK = 64, HALF = 128, HTB = HALF * BK * 2, STAGE_BYTES = 8 * HTB, NXCD = 8, WGM = 8;
DEV int lds_byte(int r, int c) { const int st = (r >> 4) * 2 + (c >> 5), rr = r & 15, cc = c & 31, ob = rr * 64 + cc * 2; return st * 1024 + (ob ^ (((ob >> 9) & 1) << 5)); }
DEV void stage_rc(int b, int& R, int& C) { const int st = b / 1024, sb = b % 1024, swz = sb ^ (((sb >> 9) & 1) << 5); R = (st >> 1) * 16 + swz / 64; C = (st & 1) * 32 + (swz % 64) / 2; }
DEV int perm32(int rho) { const int n = rho >> 4, i = rho & 15; return 8 * (i >> 2) + 4 * n + (i & 3); }
struct Unit { int pm, pn; };
struct Gemm { const bf16_t* A; const bf16_t* Bt; int M, N, K; };
struct StaticOrder {
    int nM, nN, nwg, G, c;
    DEV void init(int M, int N, int G_, int c_) { nM = M / BM; nN = N / BM; nwg = nM * nN; G = G_; c = c_; }
    DEV bool next(int i, Unit& u) const {
        const long L = (long)i * G + c; if (L >= nwg) return false;
        int wgid = (int)L; { const int q = nwg / NXCD, r = nwg % NXCD, xcd = wgid % NXCD, off = wgid / NXCD; wgid = (xcd < r ? xcd * (q + 1) : r * (q + 1) + (xcd - r) * q) + off; }
        const int nig = WGM * nN, gid = wgid / nig, fm = gid * WGM, gsz = (nM - fm) < WGM ? (nM - fm) : WGM;
        u.pm = fm + ((wgid % nig) % gsz); u.pn = (wgid % nig) / gsz; return true;
    }
};
template <class Epi>
DEV void gemm_phase(LAS unsigned char* lds, const Gemm g, const StaticOrder& S, const Epi& E, int wv) {
    const int tid = opaque_tid(wv), wid = __builtin_amdgcn_readfirstlane(tid >> 6), lane = tid & 63, wr = wid >> 2, wc = wid & 3, fr = lane & 15, fq = lane >> 4;
    const int K = g.K, nt = K / BK;
    unsigned voffA[2], voffB[2];
#pragma unroll
    for (int i = 0; i < 2; ++i) { int R, C; stage_rc(tid * 16 + i * 8192, R, C); const int Rb = (R & ~31) + perm32(R & 31);
        voffA[i] = (unsigned)(R * K + C) * 2u; voffB[i] = (unsigned)(Rb * K + C) * 2u; }
    const size_t kstep = (size_t)(BK * 2);
    const size_t hstep = (size_t)HALF * K * 2;
    const size_t tstep = 2 * hstep;
    const unsigned ldsw = (unsigned)wid * 1024u;
    const int aoff = lds_byte(wr * 64 + fr, fq * 8), boff = lds_byte(wc * 32 + fr, fq * 8);
#define PG8_SA(b, h) (((b) * 2 + (h)) * HTB)
#define PG8_SB(b, h) ((4 + (b) * 2 + (h)) * HTB)
#define PG8_STAGE(bufoff, gbase, voff) do { _Pragma("unroll") for (int _i = 0; _i < 2; ++_i) \
        __builtin_amdgcn_global_load_lds((const unsigned*)((const char*)(gbase) + (voff)[_i]), (LAS unsigned*)(lds + (bufoff) + ldsw + _i * 8192), 16, 0, 0); } while (0)
#define PG8_LDA(dst, b, h) do { _Pragma("unroll") for (int m = 0; m < 4; ++m) _Pragma("unroll") for (int k = 0; k < 2; ++k) dst[m][k] = *(const LAS bf16x8*)(lds + PG8_SA(b, h) + aoff + m * 2048 + k * 1024); } while (0)
#define PG8_LDB(dst, b, h) do { _Pragma("unroll") for (int n = 0; n < 2; ++n) _Pragma("unroll") for (int k = 0; k < 2; ++k) dst[n][k] = *(const LAS bf16x8*)(lds + PG8_SB(b, h) + boff + n * 2048 + k * 1024); } while (0)
#define PG8_MMA(ai, bj, At, Bt) do { __builtin_amdgcn_s_setprio(1); _Pragma("unroll") for (int m = 0; m < 4; ++m) _Pragma("unroll") for (int n = 0; n < 2; ++n) _Pragma("unroll") for (int k = 0; k < 2; ++k) \
        acc[ai][bj][m][n] = __builtin_amdgcn_mfma_f32_16x16x32_bf16(Bt[n][k], At[m][k], acc[ai][bj][m][n], 0, 0, 0); __builtin_amdgcn_s_setprio(0); } while (0)
#define PG8_WAIT_V(n) asm volatile("s_waitcnt vmcnt(" #n ")" ::: "memory")
#define PG8_WAIT_L(n) asm volatile("s_waitcnt lgkmcnt(" #n ")" ::: "memory")
#define PG8_BAR __builtin_amdgcn_s_barrier()
#define PG8_SCHED __builtin_amdgcn_sched_barrier(0)
    Unit cur, nxt; int ui = 0;
    if (!S.next(0, cur)) return;
    f32x4 acc[2][2][4][2];
#pragma unroll
    for (int a = 0; a < 2; ++a)
#pragma unroll
        for (int b = 0; b < 2; ++b)
#pragma unroll
            for (int m = 0; m < 4; ++m)
#pragma unroll
                for (int n = 0; n < 2; ++n) acc[a][b][m][n] = (f32x4){0.f, 0.f, 0.f, 0.f};
    bf16x8 At[4][2], B0[2][2], B1[2][2];
    const char* cA = (const char*)g.A + (size_t)cur.pm * tstep; const char* cB = (const char*)g.Bt + (size_t)cur.pn * tstep;
    PG8_STAGE(PG8_SB(0, 0), cB, voffB); PG8_STAGE(PG8_SA(0, 0), cA, voffA); PG8_STAGE(PG8_SB(0, 1), cB + hstep, voffB); PG8_STAGE(PG8_SA(0, 1), cA + hstep, voffA);
    if (wr == 1) PG8_BAR;
    PG8_WAIT_V(4); PG8_BAR;
    PG8_STAGE(PG8_SB(1, 0), cB + kstep, voffB); PG8_STAGE(PG8_SA(1, 0), cA + kstep, voffA); PG8_STAGE(PG8_SB(1, 1), cB + hstep + kstep, voffB);
    PG8_WAIT_V(6); PG8_BAR;
    for (;;) {
        const bool has_next = S.next(ui + 1, nxt);
        const char* nA = has_next ? (const char*)g.A + (size_t)nxt.pm * tstep : cA; const char* nB = has_next ? (const char*)g.Bt + (size_t)nxt.pn * tstep : cB;
        for (int t = 0; t < nt; t += 2) {
            const bool last = (t == nt - 2);
            const char* a1 = cA + (size_t)(t + 1) * kstep;
            const char* a2 = last ? nA : cA + (size_t)(t + 2) * kstep; const char* b2 = last ? nB : cB + (size_t)(t + 2) * kstep;
            const char* a3 = a2 + kstep; const char* b3 = b2 + kstep;
            PG8_LDB(B0, 0, 0); PG8_SCHED; PG8_LDA(At, 0, 0); PG8_STAGE(PG8_SA(1, 1), a1 + hstep, voffA);
            PG8_WAIT_L(8); PG8_BAR; PG8_WAIT_L(0); PG8_MMA(0, 0, At, B0); PG8_BAR; PG8_SCHED;
            PG8_LDB(B1, 0, 1); PG8_STAGE(PG8_SB(0, 0), b2, voffB);
            PG8_BAR; PG8_WAIT_L(0); PG8_MMA(0, 1, At, B1); PG8_BAR;
            PG8_LDA(At, 0, 1); PG8_STAGE(PG8_SA(0, 0), a2, voffA);
            PG8_BAR; PG8_WAIT_L(0); PG8_MMA(1, 0, At, B0); PG8_BAR; PG8_SCHED;
            PG8_STAGE(PG8_SB(0, 1), b2 + hstep, voffB);
            PG8_WAIT_V(6); PG8_BAR; PG8_MMA(1, 1, At, B1); PG8_BAR;
            PG8_LDB(B0, 1, 0); PG8_SCHED; PG8_LDA(At, 1, 0); PG8_STAGE(PG8_SA(0, 1), a2 + hstep, voffA);
            PG8_WAIT_L(8); PG8_BAR; PG8_WAIT_L(0); PG8_MMA(0, 0, At, B0); PG8_BAR; PG8_SCHED;
            PG8_LDB(B1, 1, 1); PG8_STAGE(PG8_SB(1, 0), b3, voffB);
            PG8_BAR; PG8_WAIT_L(0); PG8_MMA(0, 1, At, B1); PG8_BAR;
            PG8_LDA(At, 1, 1); PG8_STAGE(PG8_SA(1, 0), a3, voffA);
            PG8_BAR; PG8_WAIT_L(0); PG8_MMA(1, 0, At, B0); PG8_BAR; PG8_SCHED;
            PG8_STAGE(PG8_SB(1, 1), b3 + hstep, voffB);
            PG8_WAIT_V(6); PG8_BAR; PG8_MMA(1, 1, At, B1); PG8_BAR;
        }
        E(acc, cur, wr, wc, fr, fq);
        if (!has_next) break;
#pragma unroll
        for (int a = 0; a < 2; ++a)
#pragma unroll
            for (int b = 0; b < 2; ++b)
#pragma unroll
                for (int m = 0; m < 4; ++m)
#pragma unroll
                    for (int n = 0; n < 2; ++n) acc[a][b][m][n] = (f32x4){0.f, 0.f, 0.f, 0.f};
        cur = nxt; cA = nA; cB = nB; ++ui;
    }
    PG8_WAIT_V(0);
    if (wr == 0) PG8_BAR;
    PG8_BAR;
#undef PG8_SA
#undef PG8_SB
#undef PG8_STAGE
#undef PG8_LDA
#undef PG8_LDB
#undef PG8_MMA
#undef PG8_WAIT_V
#undef PG8_WAIT_L
#undef PG8_BAR
#undef PG8_SCHED
}
}
using pg8::Unit;

#define EPI_ROWS_BEGIN _Pragma("unroll") for (int ai = 0; ai < 2; ++ai) _Pragma("unroll") for (int m = 0; m < 4; ++m) { const int row = u.pm * 256 + ai * 128 + wr * 64 + m * 16 + fr;
#define EPI_COLS_BEGIN _Pragma("unroll") for (int bj = 0; bj < 2; ++bj) { const int c8 = u.pn * 256 + bj * 128 + wc * 32 + fq * 8; f32x4 v0 = acc[ai][bj][m][0], v1 = acc[ai][bj][m][1];
#define EPI_END } }

struct EpiP {
    bf16_t* P; const float* ct; const float* st;
    DEV void operator()(const f32x4 (&acc)[2][2][4][2], const Unit& u, int wr, int wc, int fr, int fq) const {
        EPI_ROWS_BEGIN EPI_COLS_BEGIN
            const int cb = u.pn * 256 + bj * 128 + wc * 32;
            const bool rope = ((cb & 63) == 0) && ((cb >= C_Q && cb < C_V) || (cb >= C_QI && cb < C_WI));
            if (rope) {
                f32x4 p0, p1;
#pragma unroll
                for (int i = 0; i < 4; ++i) { p0[i] = __shfl_xor(v0[i], 16); p1[i] = __shfl_xor(v1[i], 16); }
                if (fq < 2) {
                    const f32x4 c0 = *(const f32x4*)(ct + (size_t)row * 8), c1 = *(const f32x4*)(ct + (size_t)row * 8 + 4);
                    const f32x4 s0 = *(const f32x4*)(st + (size_t)row * 8), s1 = *(const f32x4*)(st + (size_t)row * 8 + 4);
                    const float sg = (fq == 0) ? -1.f : 1.f;
                    v0 = v0 * c0 + sg * (p0 * s0); v1 = v1 * c1 + sg * (p1 * s1);
                }
            }
            u32x4 o; o[0] = cvt_pk_bf16(v0[0], v0[1]); o[1] = cvt_pk_bf16(v0[2], v0[3]); o[2] = cvt_pk_bf16(v1[0], v1[1]); o[3] = cvt_pk_bf16(v1[2], v1[3]);
            *(u32x4*)(P + (size_t)row * NINP + c8) = o;
        EPI_END
    }
};
struct EpiStore {
    bf16_t* O; int ldc;
    DEV void operator()(const f32x4 (&acc)[2][2][4][2], const Unit& u, int wr, int wc, int fr, int fq) const {
        EPI_ROWS_BEGIN EPI_COLS_BEGIN
            u32x4 o; o[0] = cvt_pk_bf16(v0[0], v0[1]); o[1] = cvt_pk_bf16(v0[2], v0[3]); o[2] = cvt_pk_bf16(v1[0], v1[1]); o[3] = cvt_pk_bf16(v1[2], v1[3]);
            *(u32x4*)(O + (size_t)row * ldc + c8) = o;
        EPI_END
    }
};
struct EpiGlu {
    const bf16_t* Z; bf16_t* YB;
    DEV void operator()(const f32x4 (&acc)[2][2][4][2], const Unit& u, int wr, int wc, int fr, int fq) const {
        EPI_ROWS_BEGIN EPI_COLS_BEGIN
            float z[8]; unpack8(*(const u32x4*)(Z + (size_t)row * 512 + c8), z);
            float o[8];
#pragma unroll
            for (int i = 0; i < 4; ++i) { o[i] = z[i] * sigmoidf_(v0[i]); o[4 + i] = z[4 + i] * sigmoidf_(v1[i]); }
            *(u32x4*)(YB + (size_t)row * 512 + c8) = pack8(o);
        EPI_END
    }
};
template <int MODE> struct EpiMerge {
    const bf16_t* G;
    float* MF; bf16_t* MB;
    DEV void operator()(const f32x4 (&acc)[2][2][4][2], const Unit& u, int wr, int wc, int fr, int fq) const {
        EPI_ROWS_BEGIN EPI_COLS_BEGIN
            float gt[8]; unpack8(*(const u32x4*)(G + (size_t)row * NINP + c8), gt);
            float o[8];
#pragma unroll
            for (int i = 0; i < 4; ++i) { o[i] = sigmoidf_(gt[i]) * v0[i]; o[4 + i] = sigmoidf_(gt[4 + i]) * v1[i]; }
            float* mp = MF + (size_t)row * D + c8;
            if (MODE != 0) { const f32x4 a0 = *(const f32x4*)mp, a1 = *(const f32x4*)(mp + 4);
#pragma unroll
                for (int i = 0; i < 4; ++i) { o[i] += a0[i]; o[4 + i] += a1[i]; } }
            if (MODE != 2) { *(f32x4*)mp = (f32x4){o[0], o[1], o[2], o[3]}; *(f32x4*)(mp + 4) = (f32x4){o[4], o[5], o[6], o[7]}; }
            else *(u32x4*)(MB + (size_t)row * D + c8) = pack8(o);
        EPI_END
    }
};
struct EpiResid {
    const float* res; float* out;
    DEV void operator()(const f32x4 (&acc)[2][2][4][2], const Unit& u, int wr, int wc, int fr, int fq) const {
        EPI_ROWS_BEGIN EPI_COLS_BEGIN
            const float* rp = res + (size_t)row * D + c8; float* op = out + (size_t)row * D + c8;
            const f32x4 r0 = *(const f32x4*)rp, r1 = *(const f32x4*)(rp + 4);
            *(f32x4*)op = r0 + v0; *(f32x4*)(op + 4) = r1 + v1;
        EPI_END
    }
};

template <class Epi> DEV void run_gemm(unsigned char* shm, int wv, const bf16_t* A, const bf16_t* Bt, int M, int N, int K, const Epi& E) {
    pg8::Gemm g; g.A = A; g.Bt = Bt; g.M = M; g.N = N; g.K = K;
    pg8::StaticOrder So; So.init(M, N, (int)gridDim.x, (int)blockIdx.x);
    pg8::gemm_phase<Epi>((LAS unsigned char*)shm, g, So, E, wv);
}

DEV void convT(const float* __restrict__ src, int K, int N, bf16_t* __restrict__ dst, int Npad, unsigned char* shm, int wv) {
    float* tile = (float*)shm;
    const int tid = opaque_tid(wv), tk = K / 64, tn = Npad / 64;
    for (int t = blockIdx.x; t < tk * tn; t += gridDim.x) {
        const int n0 = (t % tn) * 64, k0 = (t / tn) * 64;
        __syncthreads();
#pragma unroll
        for (int i = 0; i < 8; ++i) { const int k = i * 8 + (tid >> 6), n = tid & 63; tile[k * 65 + n] = (n0 + n < N) ? src[(size_t)(k0 + k) * N + n0 + n] : 0.f; }
        __syncthreads();
        const int n = tid >> 3, ks = (tid & 7) * 8;
        float f[8];
#pragma unroll
        for (int j = 0; j < 8; ++j) f[j] = tile[(ks + j) * 65 + n];
        *(u32x4*)(dst + (size_t)(n0 + n) * K + k0 + ks) = pack8(f);
    }
    __syncthreads();
}

DEV void rmsnorm_bf16(const float* x, const float* g, bf16_t* out, int rows, int wv) {
    const int tid_ = opaque_tid(wv), lane = tid_ & 63, wid = tid_ >> 6;
    for (int r = blockIdx.x * 8 + wid; r < rows; r += gridDim.x * 8) {
        const f32x4* xr = (const f32x4*)(x + (size_t)r * D);
        f32x4 v[8]; float ss = 0.f;
#pragma unroll
        for (int j = 0; j < 8; ++j) { v[j] = xr[j * 64 + lane]; ss += v[j][0] * v[j][0] + v[j][1] * v[j][1] + v[j][2] * v[j][2] + v[j][3] * v[j][3]; }
        ss = wave_sum_f(ss);
        const float rstd = rsqrtf(ss * (1.f / D) + 1e-6f);
#pragma unroll
        for (int j = 0; j < 8; ++j) { const f32x4 gg = ((const f32x4*)g)[j * 64 + lane];
            u32x2 o; o[0] = cvt_pk_bf16(v[j][0] * rstd * gg[0], v[j][1] * rstd * gg[1]); o[1] = cvt_pk_bf16(v[j][2] * rstd * gg[2], v[j][3] * rstd * gg[3]);
            *(u32x2*)(out + (size_t)r * D + (j * 64 + lane) * 4) = o; }
    }
}
DEV void rmsnorm_f32_inplace(float* x, const float* g, int rows, int wv) {
    const int tid_ = opaque_tid(wv), lane = tid_ & 63, wid = tid_ >> 6;
    for (int r = blockIdx.x * 8 + wid; r < rows; r += gridDim.x * 8) {
        f32x4* xr = (f32x4*)(x + (size_t)r * D);
        f32x4 v[8]; float ss = 0.f;
#pragma unroll
        for (int j = 0; j < 8; ++j) { v[j] = xr[j * 64 + lane]; ss += v[j][0] * v[j][0] + v[j][1] * v[j][1] + v[j][2] * v[j][2] + v[j][3] * v[j][3]; }
        ss = wave_sum_f(ss);
        const float rstd = rsqrtf(ss * (1.f / D) + 1e-6f);
#pragma unroll
        for (int j = 0; j < 8; ++j) { const f32x4 gg = ((const f32x4*)g)[j * 64 + lane]; xr[j * 64 + lane] = v[j] * rstd * gg; }
    }
}

DEV void ssm_coef(const Params& p, int l, int g, int n, float& abr, float& abi, float (&Br)[16], float (&Bi)[16]) {
    const int gi = l * 32 + g;
    const float are = p.in[5][gi * 64 + n], aim = p.in[6][gi * 64 + n], dt = expf(p.in[7][gi]);
    const float mag = expf(dt * are); float sn, cs; sincos_acc(dt * aim, sn, cs);
    abr = mag * cs; abi = mag * sn;
    const float nr = abr - 1.f, ni = abi, den = are * are + aim * aim;
    const float qr = (nr * are + ni * aim) / den, qi = (ni * are - nr * aim) / den;
    const float* bre = p.in[8] + (size_t)(gi * 64 + n) * 16; const float* bim = p.in[9] + (size_t)(gi * 64 + n) * 16;
#pragma unroll
    for (int q = 0; q < 16; ++q) { const float br = bre[q], bi = bim[q]; Br[q] = qr * br - qi * bi; Bi[q] = qr * bi + qi * br; }
}
DEV void load_u16(const bf16_t* ptr, float (&u)[16]) {
    const u32x4 a = *(const u32x4*)ptr, b = *(const u32x4*)(ptr + 8);
#pragma unroll
    for (int i = 0; i < 4; ++i) { u[2 * i] = bf_lo(a[i]); u[2 * i + 1] = bf_hi(a[i]); u[8 + 2 * i] = bf_lo(b[i]); u[8 + 2 * i + 1] = bf_hi(b[i]); }
}
DEV void ssm_pass1(const Params& p, int l, const bf16_t* P, float* XEND, int g, int c, int lane) {
    float abr, abi, Br[16], Bi[16]; ssm_coef(p, l, g, lane, abr, abi, Br, Bi);
    float xr = 0.f, xi = 0.f;
    for (int t = c * 128; t < c * 128 + 128; ++t) {
        float u[16]; load_u16(P + (size_t)t * NINP + C_SSMU + g * 16, u);
        float br = 0.f, bi = 0.f;
#pragma unroll
        for (int q = 0; q < 16; ++q) { br += Br[q] * u[q]; bi += Bi[q] * u[q]; }
        const float nr = abr * xr - abi * xi + br, ni = abr * xi + abi * xr + bi; xr = nr; xi = ni;
    }
    float* xe = XEND + ((size_t)(g * 64 + c) * 64 + lane) * 2; xe[0] = xr; xe[1] = xi;
}
DEV void ssm_pass2(const Params& p, int l, const bf16_t* P, const float* XEND, bf16_t* Z, int g, int c, int lane) {
    float abr, abi, Br[16], Bi[16]; ssm_coef(p, l, g, lane, abr, abi, Br, Bi);
    const int gi = l * 32 + g;
    float Cr[16], Ci[16], Dp[16];
#pragma unroll
    for (int q = 0; q < 16; ++q) { Cr[q] = p.in[10][(size_t)(gi * 16 + q) * 64 + lane]; Ci[q] = p.in[11][(size_t)(gi * 16 + q) * 64 + lane]; Dp[q] = p.in[12][l * 512 + g * 16 + q] * (1.f / 64.f); }
    float pr = abr, pi = abi;
#pragma unroll
    for (int i = 0; i < 7; ++i) { const float nr = pr * pr - pi * pi, ni = 2.f * pr * pi; pr = nr; pi = ni; }
    float xr = 0.f, xi = 0.f;
    for (int cc = 0; cc < c; ++cc) { const float* xe = XEND + ((size_t)(g * 64 + cc) * 64 + lane) * 2; const float er = xe[0], ei = xe[1];
        const float nr = pr * xr - pi * xi + er, ni = pr * xi + pi * xr + ei; xr = nr; xi = ni; }
    const bool b5 = lane & 32, b4 = lane & 16, b3 = lane & 8, b2 = lane & 4;
    const int pidx = (b5 ? 8 : 0) + (b4 ? 4 : 0) + (b3 ? 2 : 0) + (b2 ? 1 : 0);
    for (int t = c * 128; t < c * 128 + 128; ++t) {
        float u[16]; load_u16(P + (size_t)t * NINP + C_SSMU + g * 16, u);
        float br = 0.f, bi = 0.f;
#pragma unroll
        for (int q = 0; q < 16; ++q) { br += Br[q] * u[q]; bi += Bi[q] * u[q]; }
        const float nr = abr * xr - abi * xi + br, ni = abr * xi + abi * xr + bi; xr = nr; xi = ni;
        float v[16];
#pragma unroll
        for (int q = 0; q < 16; ++q) v[q] = Cr[q] * xr - Ci[q] * xi + Dp[q] * u[q];
        float w8[8], w4[4], w2[2], w1;
#pragma unroll
        for (int q = 0; q < 8; ++q) { const float keep = b5 ? v[q + 8] : v[q], send = b5 ? v[q] : v[q + 8]; w8[q] = keep + __shfl_xor(send, 32); }
#pragma unroll
        for (int q = 0; q < 4; ++q) { const float keep = b4 ? w8[q + 4] : w8[q], send = b4 ? w8[q] : w8[q + 4]; w4[q] = keep + __shfl_xor(send, 16); }
#pragma unroll
        for (int q = 0; q < 2; ++q) { const float keep = b3 ? w4[q + 2] : w4[q], send = b3 ? w4[q] : w4[q + 2]; w2[q] = keep + __shfl_xor(send, 8); }
        { const float keep = b2 ? w2[1] : w2[0], send = b2 ? w2[0] : w2[1]; w1 = keep + __shfl_xor(send, 4); }
        w1 += __shfl_xor(w1, 2); w1 += __shfl_xor(w1, 1);
        if ((lane & 3) == 0) Z[(size_t)t * 512 + g * 16 + pidx] = (bf16_t)(cvt_pk_bf16(gelu_tanh(w1), 0.f) & 0xffffu);
    }
}

DEV void count_ge(int& c, unsigned key, unsigned cand) {
    asm volatile("v_cmp_le_u32_e32 vcc, %2, %1\n\tv_addc_co_u32_e32 %0, vcc, 0, %0, vcc" : "+v"(c) : "v"(key), "s"(cand) : "vcc");
}
template <int NR>
DEV void select_topk(const float* __restrict__ sc, int t, int lane, int* __restrict__ idx_out) {
    unsigned key[NR];
#pragma unroll
    for (int j = 0; j < NR; ++j) { const int s = j * 64 + lane; const bool ok = s <= t; const float v = ok ? sc[s] : 0.f;
        unsigned u = __float_as_uint(v); u = (u & 0x80000000u) ? ~u : (u | 0x80000000u); key[j] = ok ? u : 0u; }
    unsigned thr = 0u;
    for (int bit = 31; bit >= 0; --bit) {
        const unsigned cand = __builtin_amdgcn_readfirstlane(thr | (1u << bit));
        int c = 0;
#pragma unroll
        for (int j = 0; j < NR; ++j) count_ge(c, key[j], cand);
        c = __builtin_amdgcn_readfirstlane(wave_sum_i(c));
        if (c >= 256) { thr = cand; if (c == 256) break; }
    }
    int cgt = 0;
    { const unsigned thr1 = __builtin_amdgcn_readfirstlane(thr + 1u);
#pragma unroll
      for (int j = 0; j < NR; ++j) count_ge(cgt, key[j], thr1); }
    cgt = __builtin_amdgcn_readfirstlane(wave_sum_i(cgt));
    int need = 256 - cgt, base = 0;
#pragma unroll
    for (int j = 0; j < NR; ++j) {
        const bool gt = key[j] > thr, eq = key[j] == thr;
        const unsigned long long meq = __ballot(eq);
        const int peq = (int)__builtin_amdgcn_mbcnt_hi((unsigned)(meq >> 32), __builtin_amdgcn_mbcnt_lo((unsigned)meq, 0u));
        const bool take = gt || (eq && peq < need);
        const int neq = __popcll(meq); need = (need > neq) ? need - neq : 0;
        const unsigned long long mt = __ballot(take);
        const int pos = base + (int)__builtin_amdgcn_mbcnt_hi((unsigned)(mt >> 32), __builtin_amdgcn_mbcnt_lo((unsigned)mt, 0u));
        if (take && pos < 256) idx_out[pos] = j * 64 + lane;
        base += __popcll(mt);
        __builtin_amdgcn_sched_barrier(0);
    }
}
DEV void indexer_task(const bf16_t* P, int t0, float* sc, int* IDX, int lane) {
    int ln = lane; asm volatile("" : "+v"(ln));
    const int hh = ln >> 5, r = ln & 31;
    const int jj = r >> 3, hb = (r >> 2) & 1, ii = r & 3;
    const int qa = 2 * hb + (jj >> 1), ha = 4 * (jj & 1) + ii;
    bf16x8 afr[4];
    { const bf16_t* ap = P + (size_t)(t0 + qa) * NINP + C_QI + ha * 64 + 8 * hh;
#pragma unroll
      for (int kk = 0; kk < 4; ++kk) afr[kk] = *(const bf16x8*)(ap + 16 * kk); }
    float w0[8], w1[8];
    unpack8(*(const u32x4*)(P + (size_t)(t0 + 2 * hh) * NINP + C_WI), w0);
    unpack8(*(const u32x4*)(P + (size_t)(t0 + 2 * hh + 1) * NINP + C_WI), w1);
    const int ntile = ((t0 + 3) >> 5) + 1;
    for (int kt = 0; kt < ntile; ++kt) {
        const int s = kt * 32 + r;
        const bf16_t* bp = P + (size_t)s * NINP + C_KI + 8 * hh;
        bf16x8 bfr[4];
#pragma unroll
        for (int kk = 0; kk < 4; ++kk) bfr[kk] = *(const bf16x8*)(bp + 16 * kk);
        f32x16 acc;
#pragma unroll
        for (int i = 0; i < 16; ++i) acc[i] = 0.f;
#pragma unroll
        for (int kk = 0; kk < 4; ++kk) acc = __builtin_amdgcn_mfma_f32_32x32x16_bf16(afr[kk], bfr[kk], acc, 0, 0, 0);
        float s0 = 0.f, s1 = 0.f;
#pragma unroll
        for (int j = 0; j < 8; ++j) { s0 += w0[j] * fmaxf(acc[j], 0.f); s1 += w1[j] * fmaxf(acc[8 + j], 0.f); }
        sc[(size_t)(2 * hh) * 8192 + s] = s0; sc[(size_t)(2 * hh + 1) * 8192 + s] = s1;
    }
    wave_mem_sync();
    for (int qq = 0; qq < 4; ++qq) {
        const int t = t0 + qq;
        if (t < 256) continue;
        const int nr = (t >> 6) + 1;
        const float* scq = sc + (size_t)qq * 8192; int* io = IDX + (size_t)t * 256;
        if (nr <= 32) select_topk<32>(scq, t, lane, io);
        else if (nr <= 64) select_topk<64>(scq, t, lane, io);
        else if (nr <= 96) select_topk<96>(scq, t, lane, io);
        else select_topk<128>(scq, t, lane, io);
    }
}

DEV void attn_query(const bf16_t* P, const int* IDX, bf16_t* YC, int t, int lane, float* lg  , int* ids  ) {
    const int nk = (t < 255) ? t + 1 : 256;
#pragma unroll
    for (int j = 0; j < 4; ++j) { const int k = lane + 64 * j; ids[k] = (t < 256) ? ((k <= t) ? k : 0) : IDX[(size_t)t * 256 + k]; }
    wave_mem_sync();
    const int fr = lane & 15, fq = lane >> 4;
    for (int g = 0; g < 4; ++g) {
        bf16x8 bq[2];
#pragma unroll
        for (int kk = 0; kk < 2; ++kk) {
            if (fr < 4) bq[kk] = *(const bf16x8*)(P + (size_t)t * NINP + C_Q + (4 * g + fr) * 64 + 32 * kk + 8 * fq);
            else { bq[kk] = (bf16x8){0, 0, 0, 0, 0, 0, 0, 0}; }
        }
        const int ntile = (nk + 15) >> 4;
        for (int tl = 0; tl < ntile; ++tl) {
            const int row = ids[tl * 16 + fr];
            const bf16_t* kp = P + (size_t)row * NINP + C_K + 64 * g + 8 * fq;
            const bf16x8 a0 = *(const bf16x8*)kp, a1 = *(const bf16x8*)(kp + 32);
            f32x4 acc = (f32x4){0.f, 0.f, 0.f, 0.f};
            acc = __builtin_amdgcn_mfma_f32_16x16x32_bf16(a0, bq[0], acc, 0, 0, 0);
            acc = __builtin_amdgcn_mfma_f32_16x16x32_bf16(a1, bq[1], acc, 0, 0, 0);
            if (fr < 4) {
#pragma unroll
                for (int i = 0; i < 4; ++i) lg[(tl * 16 + 4 * fq + i) * 4 + fr] = acc[i] * 0.125f;
            }
        }
        wave_mem_sync();
        {
            f32x4 v[4]; f32x4 mx = (f32x4){-3.0e38f, -3.0e38f, -3.0e38f, -3.0e38f};
#pragma unroll
            for (int j = 0; j < 4; ++j) { const int k = lane + 64 * j; if (k < nk) { v[j] = *(const f32x4*)(lg + k * 4);
#pragma unroll
                    for (int r = 0; r < 4; ++r) mx[r] = fmaxf(mx[r], v[j][r]); } else v[j] = (f32x4){0.f, 0.f, 0.f, 0.f}; }
#pragma unroll
            for (int r = 0; r < 4; ++r) mx[r] = wave_max_f(mx[r]);
            f32x4 sm = (f32x4){0.f, 0.f, 0.f, 0.f};
#pragma unroll
            for (int j = 0; j < 4; ++j) { const int k = lane + 64 * j;
#pragma unroll
                for (int r = 0; r < 4; ++r) { const float e = (k < nk) ? __expf(v[j][r] - mx[r]) : 0.f; v[j][r] = e; sm[r] += e; } }
#pragma unroll
            for (int r = 0; r < 4; ++r) sm[r] = 1.f / wave_sum_f(sm[r]);
#pragma unroll
            for (int j = 0; j < 4; ++j) { const int k = lane + 64 * j; *(f32x4*)(lg + k * 4) = v[j] * sm; }
        }
        wave_mem_sync();
        {
            const int dp = lane & 31, kh = lane >> 5;
            float o0[4] = {0.f, 0.f, 0.f, 0.f}, o1[4] = {0.f, 0.f, 0.f, 0.f};
            const int n2 = (nk + 1) >> 1;
            for (int k2 = 0; k2 < n2; ++k2) {
                const int k = 2 * k2 + kh;
                const int row = ids[k];
                const f32x4 pk = *(const f32x4*)(lg + k * 4);
                const unsigned vv = *(const unsigned*)(P + (size_t)row * NINP + C_V + 64 * g + 2 * dp);
                const float va = bf_lo(vv), vb = bf_hi(vv);
#pragma unroll
                for (int r = 0; r < 4; ++r) { o0[r] += pk[r] * va; o1[r] += pk[r] * vb; }
            }
#pragma unroll
            for (int r = 0; r < 4; ++r) { o0[r] += __shfl_xor(o0[r], 32); o1[r] += __shfl_xor(o1[r], 32); }
            if (kh == 0) {
#pragma unroll
                for (int r = 0; r < 4; ++r) *(unsigned*)(YC + (size_t)t * 1024 + (4 * g + r) * 64 + 2 * dp) = cvt_pk_bf16(o0[r], o1[r]);
            }
        }
        wave_mem_sync();
    }
}

__global__ __launch_bounds__(512, 2) void fwd_megakernel(Params p) {
    extern __shared__ __attribute__((aligned(16))) unsigned char shm[];
    cg::grid_group grid = cg::this_grid();
    const int wv = __builtin_amdgcn_readfirstlane((int)threadIdx.x >> 6);
#define PHASE_IDS const int tid = opaque_tid(wv), lane = tid & 63, wid = __builtin_amdgcn_readfirstlane(tid >> 6); const int gw = blockIdx.x * 8 + wid, nw = gridDim.x * 8; const int gt = blockIdx.x * 512 + tid, nthr = gridDim.x * 512; (void)lane; (void)gw; (void)nw; (void)gt; (void)nthr;
    unsigned char* ws = p.ws;
    float* CT = (float*)(ws + WS_CT); float* ST = (float*)(ws + WS_ST);
    bf16_t* H = (bf16_t*)(ws + WS_H); bf16_t* P = (bf16_t*)(ws + WS_P);
    bf16_t* YA = (bf16_t*)(ws + WS_YA); bf16_t* YB = (bf16_t*)(ws + WS_YB); bf16_t* Z = (bf16_t*)(ws + WS_Z); bf16_t* YC = (bf16_t*)(ws + WS_YC);
    bf16_t* MB = (bf16_t*)(ws + WS_MB); int* IDX = (int*)(ws + WS_IDX); float* XEND = (float*)(ws + WS_XEND);
    bf16_t* UP = (bf16_t*)(ws + WS_UP); bf16_t* ACT = (bf16_t*)(ws + WS_ACT); float* SC = (float*)(ws + WS_SC); float* MF = (float*)(ws + WS_MF);

    for (int l = 0; l < 2; ++l) {
        unsigned char* wl = ws + WS_W + (size_t)l * WL_SIZE;
        convT(p.in[3] + (size_t)l * D * NIN, D, NIN, (bf16_t*)(wl + WL_WIN), NINP, shm, wv);
        convT(p.in[14] + (size_t)l * 512 * D, 512, D, (bf16_t*)(wl + WL_WA), D, shm, wv);
        convT(p.in[15] + (size_t)l * 512 * D, 512, D, (bf16_t*)(wl + WL_WB), D, shm, wv);
        convT(p.in[16] + (size_t)l * 1024 * D, 1024, D, (bf16_t*)(wl + WL_WC), D, shm, wv);
        convT(p.in[13] + (size_t)l * 512 * 512, 512, 512, (bf16_t*)(wl + WL_WGLU), 512, shm, wv);
        convT(p.in[17] + (size_t)l * D * D, D, D, (bf16_t*)(wl + WL_WOUT), D, shm, wv);
        convT(p.in[19] + (size_t)l * D * DFF2, D, DFF2, (bf16_t*)(wl + WL_WUP), DFF2, shm, wv);
        convT(p.in[21] + (size_t)l * DFF * D, DFF, D, (bf16_t*)(wl + WL_WDOWN), D, shm, wv);
    }
    {
        PHASE_IDS
        const int* pos = (const int*)p.in[1];
        for (int i = gt; i < NB * S * 8; i += nthr) { const float ang = (float)pos[i >> 3] * p.inv_freq[i & 7]; float sn, cs; sincos_acc(ang, sn, cs); CT[i] = cs; ST[i] = sn; }
    }
    grid.sync();

    for (int l = 0; l < 2; ++l) {
        const unsigned char* wl = ws + WS_W + (size_t)l * WL_SIZE;
        const bf16_t* WinT = (const bf16_t*)(wl + WL_WIN); const bf16_t* WaT = (const bf16_t*)(wl + WL_WA); const bf16_t* WbT = (const bf16_t*)(wl + WL_WB);
        const bf16_t* WcT = (const bf16_t*)(wl + WL_WC); const bf16_t* WgluT = (const bf16_t*)(wl + WL_WGLU); const bf16_t* WoutT = (const bf16_t*)(wl + WL_WOUT);
        const bf16_t* WupT = (const bf16_t*)(wl + WL_WUP); const bf16_t* WdownT = (const bf16_t*)(wl + WL_WDOWN);
        for (int b = 0; b < NB; ++b) {
            const float* xin = (l == 0) ? p.in[0] + (size_t)b * S * D : p.out + (size_t)b * S * D;
            float* xres = p.out + (size_t)b * S * D;
            rmsnorm_bf16(xin, p.in[2] + l * D, H, S, wv);
            grid.sync();
            { EpiP E; E.P = P; E.ct = CT + (size_t)b * S * 8; E.st = ST + (size_t)b * S * 8; run_gemm(shm, wv, H, WinT, S, NINP, D, E); }
            grid.sync();
            {
                PHASE_IDS
                const float* cw = p.in[4] + l * 3 * 512;
                for (int it = gt; it < S * 64; it += nthr) {
                    const int t = it >> 6, c8 = (it & 63) * 8;
                    float a[8] = {0.f, 0.f, 0.f, 0.f, 0.f, 0.f, 0.f, 0.f};
#pragma unroll
                    for (int j = 0; j < 3; ++j) { const int tt = t - 2 + j; if (tt >= 0) {
                            float xx[8], cc[8]; unpack8(*(const u32x4*)(P + (size_t)tt * NINP + C_SCX + c8), xx); unpack8(*(const u32x4*)(P + (size_t)tt * NINP + C_SCC + c8), cc);
                            const f32x4 w0 = *(const f32x4*)(cw + j * 512 + c8), w1 = *(const f32x4*)(cw + j * 512 + c8 + 4);
#pragma unroll
                            for (int i = 0; i < 4; ++i) { a[i] += w0[i] * (cc[i] * xx[i]); a[4 + i] += w1[i] * (cc[4 + i] * xx[4 + i]); } } }
                    float bb[8]; unpack8(*(const u32x4*)(P + (size_t)t * NINP + C_SCB + c8), bb);
#pragma unroll
                    for (int i = 0; i < 8; ++i) a[i] *= bb[i];
                    *(u32x4*)(YA + (size_t)t * 512 + c8) = pack8(a);
                }
                for (int i = gw; i < 2048; i += nw) ssm_pass1(p, l, P, XEND, i >> 6, i & 63, lane);
                for (int i = gw; i < 2048; i += nw) {
                    const int bq = i >> 3, wq = i & 7; const int task = (wq < 4) ? bq * 4 + wq : 2047 - (bq * 4 + wq - 4);
                    indexer_task(P, task * 4, SC + (size_t)gw * 4 * 8192, IDX, lane);
                }
            }
            grid.sync();
            {
                PHASE_IDS
                for (int i = gw; i < 2048; i += nw) ssm_pass2(p, l, P, XEND, Z, i >> 6, i & 63, lane);
                float* lg = (float*)(shm + wid * 8192); int* ids = (int*)(shm + wid * 8192 + 4096);
                for (int t = gw; t < S; t += nw) attn_query(P, IDX, YC, t, lane, lg, ids);
            }
            grid.sync();
            { EpiGlu E; E.Z = Z; E.YB = YB; run_gemm(shm, wv, Z, WgluT, S, 512, 512, E); }
            grid.sync();
            { EpiMerge<0> E; E.G = P + C_GA; E.MF = MF; E.MB = MB; run_gemm(shm, wv, YA, WaT, S, D, 512, E); }
            { EpiMerge<1> E; E.G = P + C_GC; E.MF = MF; E.MB = MB; run_gemm(shm, wv, YC, WcT, S, D, 1024, E); }
            { EpiMerge<2> E; E.G = P + C_GB; E.MF = MF; E.MB = MB; run_gemm(shm, wv, YB, WbT, S, D, 512, E); }
            grid.sync();
            { EpiResid E; E.res = xin; E.out = xres; run_gemm(shm, wv, MB, WoutT, S, D, D, E); }
            grid.sync();
            rmsnorm_bf16(xres, p.in[18] + l * D, H, S, wv);
            grid.sync();
            { EpiStore E; E.O = UP; E.ldc = DFF2; run_gemm(shm, wv, H, WupT, S, DFF2, D, E); }
            grid.sync();
            {
                PHASE_IDS
                const float* fw = p.in[20] + (size_t)l * 3 * DFF2;
                for (int it = gt; it < S * 704; it += nthr) {
                    const int t = it / 704, c8 = (it - t * 704) * 8;
                    float G[8] = {0.f, 0.f, 0.f, 0.f, 0.f, 0.f, 0.f, 0.f}, U[8] = {0.f, 0.f, 0.f, 0.f, 0.f, 0.f, 0.f, 0.f};
#pragma unroll
                    for (int j = 0; j < 3; ++j) { const int tt = t - 2 + j; if (tt >= 0) {
                            float gg[8], uu[8]; unpack8(*(const u32x4*)(UP + (size_t)tt * DFF2 + c8), gg); unpack8(*(const u32x4*)(UP + (size_t)tt * DFF2 + DFF + c8), uu);
                            const f32x4 g0 = *(const f32x4*)(fw + j * DFF2 + c8), g1 = *(const f32x4*)(fw + j * DFF2 + c8 + 4);
                            const f32x4 u0 = *(const f32x4*)(fw + j * DFF2 + DFF + c8), u1 = *(const f32x4*)(fw + j * DFF2 + DFF + c8 + 4);
#pragma unroll
                            for (int i = 0; i < 4; ++i) { G[i] += g0[i] * gg[i]; G[4 + i] += g1[i] * gg[4 + i]; U[i] += u0[i] * uu[i]; U[4 + i] += u1[i] * uu[4 + i]; } } }
                    float o[8];
#pragma unroll
                    for (int i = 0; i < 8; ++i) o[i] = G[i] * sigmoidf_(G[i]) * U[i];
                    *(u32x4*)(ACT + (size_t)t * DFF + c8) = pack8(o);
                }
            }
            grid.sync();
            { EpiResid E; E.res = xres; E.out = xres; run_gemm(shm, wv, ACT, WdownT, S, D, DFF, E); }
            grid.sync();
        }
    }
    rmsnorm_f32_inplace(p.out, p.in[22], NB * S, wv);
}

extern "C" void kernel_launch(void* const* d_in, const int* in_sizes, int n_in, void* d_out, int out_size, void* d_ws, size_t ws_size, hipStream_t stream) {
    static int grid_blocks = 0;
    if (!grid_blocks) {
        if (n_in != 23 || ws_size < WS_END) { fprintf(stderr, "kernel_launch: unexpected n_in %d or ws_size %zu < %zu\n", n_in, ws_size, (size_t)WS_END); grid_blocks = -1; return; }
        int dev = 0, cus = 0, per_cu = 0;
        hipGetDevice(&dev);
        hipDeviceGetAttribute(&cus, hipDeviceAttributeMultiprocessorCount, dev);
        if (hipFuncSetAttribute((const void*)fwd_megakernel, hipFuncAttributeMaxDynamicSharedMemorySize, LDS_BYTES) != hipSuccess) fprintf(stderr, "kernel_launch: hipFuncSetAttribute failed\n");
        if (hipOccupancyMaxActiveBlocksPerMultiprocessor(&per_cu, (const void*)fwd_megakernel, 512, LDS_BYTES) != hipSuccess || per_cu < 1) { per_cu = 1; (void)hipGetLastError(); }
        grid_blocks = cus * per_cu;
        if (grid_blocks > 256) grid_blocks = 256;
    }
    if (grid_blocks < 0) return;
    Params p{};
    for (int i = 0; i < 23; ++i) p.in[i] = (const float*)d_in[i];
    p.out = (float*)d_out; p.ws = (unsigned char*)d_ws;
    for (int i = 0; i < 8; ++i) p.inv_freq[i] = (float)pow(500000.0, -(double)(2 * i) / 16.0);
    void* args[] = {&p};
    hipError_t e = hipLaunchCooperativeKernel((const void*)fwd_megakernel, dim3(grid_blocks), dim3(512), args, LDS_BYTES, stream);
    if (e != hipSuccess) fprintf(stderr, "cooperative launch failed: %s (grid %d)\n", hipGetErrorString(e), grid_blocks);
}
```

```cpp
#include <hip/hip_runtime.h>
#include <hip/hip_cooperative_groups.h>
#include <cstdio>
namespace cg = cooperative_groups;

#define DEV __device__ __forceinline__
#define LAS __attribute__((address_space(3)))
typedef unsigned short bf16_t;
typedef short bf16x8 __attribute__((ext_vector_type(8)));
typedef float f32x4 __attribute__((ext_vector_type(4)));
typedef float f32x16 __attribute__((ext_vector_type(16)));
typedef unsigned u32x4 __attribute__((ext_vector_type(4)));
typedef unsigned u32x2 __attribute__((ext_vector_type(2)));
typedef float f32x2_t __attribute__((ext_vector_type(2)));
typedef int int2_t __attribute__((ext_vector_type(2)));

constexpr int D = 2048, NB = 4, S = 8192, NIN = 10312, NINP = 10496, DFF = 5632, DFF2 = 11264;
constexpr int C_SCX = 0, C_SCB = 512, C_SCC = 1024, C_SSMU = 1536, C_Q = 2048, C_K = 3072, C_V = 3328, C_QI = 3584, C_KI = 4096, C_WI = 4160,
              C_GA = 4168, C_GB = 6216, C_GC = 8264;
constexpr int WAVE_LDS = 17408;
constexpr int LDS_BYTES = 8 * WAVE_LDS + 16;

constexpr size_t WL_WIN = 0;
constexpr size_t WL_WA = WL_WIN + (size_t)NINP * D * 2;
constexpr size_t WL_WB = WL_WA + (size_t)D * 512 * 2;
constexpr size_t WL_WC = WL_WB + (size_t)D * 512 * 2;
constexpr size_t WL_WGLU = WL_WC + (size_t)D * 1024 * 2;
constexpr size_t WL_WOUT = WL_WGLU + (size_t)512 * 512 * 2;
constexpr size_t WL_WUP = WL_WOUT + (size_t)D * D * 2;
constexpr size_t WL_WDOWN = WL_WUP + (size_t)DFF2 * D * 2;
constexpr size_t WL_SIZE = WL_WDOWN + (size_t)D * DFF * 2;
constexpr size_t WS_W = 0;
constexpr size_t WS_CT = WS_W + 2 * WL_SIZE;
constexpr size_t WS_ST = WS_CT + (size_t)NB * S * 8 * 4;
constexpr size_t WS_H = WS_ST + (size_t)NB * S * 8 * 4;
constexpr size_t WS_P = WS_H + (size_t)S * D * 2;
constexpr size_t WS_YA = WS_P + (size_t)S * NINP * 2;
constexpr size_t WS_YB = WS_YA + (size_t)S * 512 * 2;
constexpr size_t WS_Z = WS_YB + (size_t)S * 512 * 2;
constexpr size_t WS_YC = WS_Z + (size_t)S * 512 * 2;
constexpr size_t WS_MB = WS_YC + (size_t)S * 1024 * 2;
constexpr size_t WS_IDX = WS_MB + (size_t)S * D * 2;
constexpr size_t WS_XEND = WS_IDX + (size_t)S * 256 * 4;
constexpr size_t WS_BIG = WS_XEND + (size_t)32 * 64 * 64 * 2 * 4;
constexpr size_t WS_UP = WS_BIG;
constexpr size_t WS_ACT = WS_UP + (size_t)S * DFF2 * 2;
constexpr size_t WS_SC = WS_BIG;
constexpr size_t WS_MF = WS_BIG;
constexpr size_t WS_BAR = WS_ACT + (size_t)S * DFF * 2;
constexpr size_t WS_H2 = WS_BAR + 16384;
constexpr size_t WS_END = WS_H2 + (size_t)S * D * 2;
static_assert(WS_SC + (size_t)2048 * 4 * 8192 * 4 <= WS_END, "score scratch must fit the aliased region");

struct Params {
    const float* in[23];
    float* out;
    unsigned char* ws;
    float inv_freq[8];
};

DEV unsigned cvt_pk_bf16(float lo, float hi) { unsigned r; asm volatile("v_cvt_pk_bf16_f32 %0, %1, %2" : "=v"(r) : "v"(lo), "v"(hi)); return r; }
DEV float bf_lo(unsigned u) { return __uint_as_float(u << 16); }
DEV float bf_hi(unsigned u) { return __uint_as_float(u & 0xffff0000u); }
DEV void unpack8(const u32x4 v, float (&f)[8]) {
#pragma unroll
    for (int i = 0; i < 4; ++i) { f[2 * i] = bf_lo(v[i]); f[2 * i + 1] = bf_hi(v[i]); }
}
DEV u32x4 pack8(const float (&f)[8]) { u32x4 r; r[0] = cvt_pk_bf16(f[0], f[1]); r[1] = cvt_pk_bf16(f[2], f[3]); r[2] = cvt_pk_bf16(f[4], f[5]); r[3] = cvt_pk_bf16(f[6], f[7]); return r; }
DEV float shx(float v, int mask, int lane) { return __int_as_float(__builtin_amdgcn_ds_bpermute((lane ^ mask) << 2, __float_as_int(v))); }
DEV float wave_sum_f(float v, int lane) {
#pragma unroll
    for (int o = 32; o; o >>= 1) v += shx(v, o, lane);
    return v;
}
DEV int wave_sum_i(int v) {
    v += __builtin_amdgcn_update_dpp(0, v, 0xB1, 0xf, 0xf, false);
    v += __builtin_amdgcn_update_dpp(0, v, 0x4E, 0xf, 0xf, false);
    v += __builtin_amdgcn_update_dpp(0, v, 0x141, 0xf, 0xf, false);
    v += __builtin_amdgcn_update_dpp(0, v, 0x140, 0xf, 0xf, false);
    return __builtin_amdgcn_readlane(v, 0) + __builtin_amdgcn_readlane(v, 16) + __builtin_amdgcn_readlane(v, 32) + __builtin_amdgcn_readlane(v, 48);
}
DEV float sigmoidf_(float x) { return 1.f / (1.f + __expf(-x)); }
DEV float gelu_tanh(float x) { const float u = 0.7978845608028654f * (x + 0.044715f * x * x * x); const float t = 1.f - 2.f / (1.f + __expf(2.f * u)); return 0.5f * x * (1.f + t); }
DEV void sincos_acc(float x, float& s, float& c) {
    const float k = rintf(x * 0.636619772367581343f);
    float y = fmaf(k, -1.57073974609375f, x); y = fmaf(k, -5.657970905303955078125e-05f, y); y = fmaf(k, -9.920936294705029468e-10f, y);
    const int q = ((int)k) & 3; const float y2 = y * y;
    const float sf = y + y * y2 * (-1.6666667163e-01f + y2 * (8.3333337680e-03f + y2 * (-1.9841270114e-04f + y2 * 2.7557314297e-06f)));
    const float cf = 1.f + y2 * (-0.5f + y2 * (4.1666667908e-02f + y2 * (-1.3888889225e-03f + y2 * (2.4801587642e-05f + y2 * (-2.7557314297e-07f)))));
    s = (q == 0) ? sf : (q == 1) ? cf : (q == 2) ? -sf : -cf;
    c = (q == 0) ? cf : (q == 1) ? -sf : (q == 2) ? -cf : sf;
}
DEV int opaque_tid(int wv) { int t; asm volatile("v_mbcnt_lo_u32_b32 %0, -1, 0\n\tv_mbcnt_hi_u32_b32 %0, -1, %0" : "=v"(t)); return (wv << 6) + t; }
DEV void wave_mem_sync() { __builtin_amdgcn_fence(__ATOMIC_SEQ_CST, "workgroup"); __builtin_amdgcn_wave_barrier(); }

namespace pg8 {
constexpr int BM = 256, BK = 64, HALF = 128, HTB = HALF * BK * 2, STAGE_BYTES = 8 * HTB, NXCD = 8, WGM = 8;
DEV int lds_byte(int r, int c) { const int st = (r >> 4) * 2 + (c >> 5), rr = r & 15, cc = c & 31, ob = rr * 64 + cc * 2; return st * 1024 + (ob ^ (((ob >> 9) & 1) << 5)); }
DEV void stage_rc(int b, int& R, int& C) { const int st = b / 1024, sb = b % 1024, swz = sb ^ (((sb >> 9) & 1) << 5); R = (st >> 1) * 16 + swz / 64; C = (st & 1) * 32 + (swz % 64) / 2; }
DEV int perm32(int rho) { const int n = rho >> 4, i = rho & 15; return 8 * (i >> 2) + 4 * n + (i & 3); }
struct Unit { int pm, pn; };
struct Gemm { const bf16_t* A; const bf16_t* Bt; int M, N, K; };
struct StaticOrder {
    int nM, nN, nwg, G, c;
    DEV void init(int M, int N, int G_, int c_) { nM = M / BM; nN = N / BM; nwg = nM * nN; G = G_; c = c_; }
    DEV bool next(int i, Unit& u) const {
        const long L = (long)i * G + c; if (L >= nwg) return false;
        int wgid = (int)L; { const int q = nwg / NXCD, r = nwg % NXCD, xcd = wgid % NXCD, off = wgid / NXCD; wgid = (xcd < r ? xcd * (q + 1) : r * (q + 1) + (xcd - r) * q) + off; }
        const int nig = WGM * nN, gid = wgid / nig, fm = gid * WGM, gsz = (nM - fm) < WGM ? (nM - fm) : WGM;
        u.pm = fm + ((wgid % nig) % gsz); u.pn = (wgid % nig) / gsz; return true;
    }
};
template <class Epi>
DEV void gemm_phase(LAS unsigned char* lds, const Gemm g, const StaticOrder& S, const Epi& E, int wv) {
    const int tid = opaque_tid(wv), wid = __builtin_amdgcn_readfirstlane(tid >> 6), lane = tid & 63, wr = wid >> 2, wc = wid & 3, fr = lane & 15, fq = lane >> 4;
    const int K = g.K, nt = K / BK;
    unsigned voffA[2], voffB[2];
#pragma unroll
    for (int i = 0; i < 2; ++i) { int R, C; stage_rc(tid * 16 + i * 8192, R, C); const int Rb = (R & ~31) + perm32(R & 31);
        voffA[i] = (unsigned)(R * K + C) * 2u; voffB[i] = (unsigned)(Rb * K + C) * 2u; }
    const size_t kstep = (size_t)(BK * 2);
    const size_t hstep = (size_t)HALF * K * 2;
    const size_t tstep = 2 * hstep;
    const unsigned ldsw = (unsigned)wid * 1024u;
    const int aoff = lds_byte(wr * 64 + fr, fq * 8), boff = lds_byte(wc * 32 + fr, fq * 8);
#define PG8_SA(b, h) (((b) * 2 + (h)) * HTB)
#define PG8_SB(b, h) ((4 + (b) * 2 + (h)) * HTB)
#define PG8_STAGE(bufoff, gbase, voff) do { _Pragma("unroll") for (int _i = 0; _i < 2; ++_i) \
        __builtin_amdgcn_global_load_lds((const unsigned*)((const char*)(gbase) + (voff)[_i]), (LAS unsigned*)(lds + (bufoff) + ldsw + _i * 8192), 16, 0, 0); } while (0)
#define PG8_LDA(dst, b, h) do { _Pragma("unroll") for (int m = 0; m < 4; ++m) _Pragma("unroll") for (int k = 0; k < 2; ++k) dst[m][k] = *(const LAS bf16x8*)(lds + PG8_SA(b, h) + aoff + m * 2048 + k * 1024); } while (0)
#define PG8_LDB(dst, b, h) do { _Pragma("unroll") for (int n = 0; n < 2; ++n) _Pragma("unroll") for (int k = 0; k < 2; ++k) dst[n][k] = *(const LAS bf16x8*)(lds + PG8_SB(b, h) + boff + n * 2048 + k * 1024); } while (0)
#define PG8_MMA(ai, bj, At, Bt) do { __builtin_amdgcn_s_setprio(1); _Pragma("unroll") for (int m = 0; m < 4; ++m) _Pragma("unroll") for (int n = 0; n < 2; ++n) _Pragma("unroll") for (int k = 0; k < 2; ++k) \
        acc[ai][bj][m][n] = __builtin_amdgcn_mfma_f32_16x16x32_bf16(Bt[n][k], At[m][k], acc[ai][bj][m][n], 0, 0, 0); __builtin_amdgcn_s_setprio(0); } while (0)
#define PG8_WAIT_V(n) asm volatile("s_waitcnt vmcnt(" #n ")" ::: "memory")
#define PG8_WAIT_L(n) asm volatile("s_waitcnt lgkmcnt(" #n ")" ::: "memory")
#define PG8_BAR __builtin_amdgcn_s_barrier()
#define PG8_SCHED __builtin_amdgcn_sched_barrier(0)
    Unit cur, nxt; int ui = 0;
    if (!S.next(0, cur)) return;
    f32x4 acc[2][2][4][2];
#pragma unroll
    for (int a = 0; a < 2; ++a)
#pragma unroll
        for (int b = 0; b < 2; ++b)
#pragma unroll
            for (int m = 0; m < 4; ++m)
#pragma unroll
                for (int n = 0; n < 2; ++n) acc[a][b][m][n] = (f32x4){0.f, 0.f, 0.f, 0.f};
    bf16x8 At[4][2], B0[2][2], B1[2][2];
    const char* cA = (const char*)g.A + (size_t)cur.pm * tstep; const char* cB = (const char*)g.Bt + (size_t)cur.pn * tstep;
    PG8_STAGE(PG8_SB(0, 0), cB, voffB); PG8_STAGE(PG8_SA(0, 0), cA, voffA); PG8_STAGE(PG8_SB(0, 1), cB + hstep, voffB); PG8_STAGE(PG8_SA(0, 1), cA + hstep, voffA);
    if (wr == 1) PG8_BAR;
    PG8_WAIT_V(4); PG8_BAR;
    PG8_STAGE(PG8_SB(1, 0), cB + kstep, voffB); PG8_STAGE(PG8_SA(1, 0), cA + kstep, voffA); PG8_STAGE(PG8_SB(1, 1), cB + hstep + kstep, voffB);
    PG8_WAIT_V(6); PG8_BAR;
    for (;;) {
        const bool has_next = S.next(ui + 1, nxt);
        const char* nA = has_next ? (const char*)g.A + (size_t)nxt.pm * tstep : cA; const char* nB = has_next ? (const char*)g.Bt + (size_t)nxt.pn * tstep : cB;
        for (int t = 0; t < nt; t += 2) {
            const bool last = (t == nt - 2);
            const char* a1 = cA + (size_t)(t + 1) * kstep;
            const char* a2 = last ? nA : cA + (size_t)(t + 2) * kstep; const char* b2 = last ? nB : cB + (size_t)(t + 2) * kstep;
            const char* a3 = a2 + kstep; const char* b3 = b2 + kstep;
            PG8_LDB(B0, 0, 0); PG8_SCHED; PG8_LDA(At, 0, 0); PG8_STAGE(PG8_SA(1, 1), a1 + hstep, voffA);
            PG8_WAIT_L(8); PG8_BAR; PG8_WAIT_L(0); PG8_MMA(0, 0, At, B0); PG8_BAR; PG8_SCHED;
            PG8_LDB(B1, 0, 1); PG8_STAGE(PG8_SB(0, 0), b2, voffB);
            PG8_BAR; PG8_WAIT_L(0); PG8_MMA(0, 1, At, B1); PG8_BAR;
            PG8_LDA(At, 0, 1); PG8_STAGE(PG8_SA(0, 0), a2, voffA);
            PG8_BAR; PG8_WAIT_L(0); PG8_MMA(1, 0, At, B0); PG8_BAR; PG8_SCHED;
            PG8_STAGE(PG8_SB(0, 1), b2 + hstep, voffB);
            PG8_WAIT_V(6); PG8_BAR; PG8_MMA(1, 1, At, B1); PG8_BAR;
            PG8_LDB(B0, 1, 0); PG8_SCHED; PG8_LDA(At, 1, 0); PG8_STAGE(PG8_SA(0, 1), a2 + hstep, voffA);
            PG8_WAIT_L(8); PG8_BAR; PG8_WAIT_L(0); PG8_MMA(0, 0, At, B0); PG8_BAR; PG8_SCHED;
            PG8_LDB(B1, 1, 1); PG8_STAGE(PG8_SB(1, 0), b3, voffB);
            PG8_BAR; PG8_WAIT_L(0); PG8_MMA(0, 1, At, B1); PG8_BAR;
            PG8_LDA(At, 1, 1); PG8_STAGE(PG8_SA(1, 0), a3, voffA);
            PG8_BAR; PG8_WAIT_L(0); PG8_MMA(1, 0, At, B0); PG8_BAR; PG8_SCHED;
            PG8_STAGE(PG8_SB(1, 1), b3 + hstep, voffB);
            PG8_WAIT_V(6); PG8_BAR; PG8_MMA(1, 1, At, B1); PG8_BAR;
        }
        E(acc, cur, wr, wc, fr, fq);
        if (!has_next) break;
#pragma unroll
        for (int a = 0; a < 2; ++a)
#pragma unroll
            for (int b = 0; b < 2; ++b)
#pragma unroll
                for (int m = 0; m < 4; ++m)
#pragma unroll
                    for (int n = 0; n < 2; ++n) acc[a][b][m][n] = (f32x4){0.f, 0.f, 0.f, 0.f};
        cur = nxt; cA = nA; cB = nB; ++ui;
    }
    PG8_WAIT_V(0);
    if (wr == 0) PG8_BAR;
    PG8_BAR;
#undef PG8_SA
#undef PG8_SB
#undef PG8_STAGE
#undef PG8_LDA
#undef PG8_LDB
#undef PG8_MMA
#undef PG8_WAIT_V
#undef PG8_WAIT_L
#undef PG8_BAR
#undef PG8_SCHED
}
}
using pg8::Unit;

#define EPI_ROWS_BEGIN _Pragma("unroll") for (int ai = 0; ai < 2; ++ai) _Pragma("unroll") for (int m = 0; m < 4; ++m) { const int row = u.pm * 256 + ai * 128 + wr * 64 + m * 16 + fr;
#define EPI_COLS_BEGIN _Pragma("unroll") for (int bj = 0; bj < 2; ++bj) { const int c8 = u.pn * 256 + bj * 128 + wc * 32 + fq * 8; f32x4 v0 = acc[ai][bj][m][0], v1 = acc[ai][bj][m][1];
#define EPI_END } }

struct EpiP {
    bf16_t* P; const float* ct; const float* st;
    int col0;
    DEV void operator()(const f32x4 (&acc)[2][2][4][2], const Unit& u, int wr, int wc, int fr, int fq) const {
        EPI_ROWS_BEGIN EPI_COLS_BEGIN
            const int cb = col0 + u.pn * 256 + bj * 128 + wc * 32;
            const bool rope = ((cb & 63) == 0) && ((cb >= C_Q && cb < C_V) || (cb >= C_QI && cb < C_WI));
            if (rope) {
                f32x4 p0, p1;
#pragma unroll
                for (int i = 0; i < 4; ++i) { p0[i] = shx(v0[i], 16, fq * 16 + fr); p1[i] = shx(v1[i], 16, fq * 16 + fr); }
                if (fq < 2) {
                    const f32x4 c0 = *(const f32x4*)(ct + (size_t)row * 8), c1 = *(const f32x4*)(ct + (size_t)row * 8 + 4);
                    const f32x4 s0 = *(const f32x4*)(st + (size_t)row * 8), s1 = *(const f32x4*)(st + (size_t)row * 8 + 4);
                    const float sg = (fq == 0) ? -1.f : 1.f;
                    v0 = v0 * c0 + sg * (p0 * s0); v1 = v1 * c1 + sg * (p1 * s1);
                }
            }
            u32x4 o; o[0] = cvt_pk_bf16(v0[0], v0[1]); o[1] = cvt_pk_bf16(v0[2], v0[3]); o[2] = cvt_pk_bf16(v1[0], v1[1]); o[3] = cvt_pk_bf16(v1[2], v1[3]);
            *(u32x4*)(P + (size_t)row * NINP + col0 + c8) = o;
        EPI_END
    }
};
struct EpiStore {
    bf16_t* O; int ldc;
    DEV void operator()(const f32x4 (&acc)[2][2][4][2], const Unit& u, int wr, int wc, int fr, int fq) const {
        EPI_ROWS_BEGIN EPI_COLS_BEGIN
            u32x4 o; o[0] = cvt_pk_bf16(v0[0], v0[1]); o[1] = cvt_pk_bf16(v0[2], v0[3]); o[2] = cvt_pk_bf16(v1[0], v1[1]); o[3] = cvt_pk_bf16(v1[2], v1[3]);
            *(u32x4*)(O + (size_t)row * ldc + c8) = o;
        EPI_END
    }
};
struct EpiGlu {
    const bf16_t* Z; bf16_t* YB;
    DEV void operator()(const f32x4 (&acc)[2][2][4][2], const Unit& u, int wr, int wc, int fr, int fq) const {
        EPI_ROWS_BEGIN EPI_COLS_BEGIN
            float z[8]; unpack8(*(const u32x4*)(Z + (size_t)row * 512 + c8), z);
            float o[8];
#pragma unroll
            for (int i = 0; i < 4; ++i) { o[i] = z[i] * sigmoidf_(v0[i]); o[4 + i] = z[4 + i] * sigmoidf_(v1[i]); }
            *(u32x4*)(YB + (size_t)row * 512 + c8) = pack8(o);
        EPI_END
    }
};
template <int MODE> struct EpiMerge {
    const bf16_t* G;
    float* MF; bf16_t* MB;
    DEV void operator()(const f32x4 (&acc)[2][2][4][2], const Unit& u, int wr, int wc, int fr, int fq) const {
        EPI_ROWS_BEGIN EPI_COLS_BEGIN
            float gt[8]; unpack8(*(const u32x4*)(G + (size_t)row * NINP + c8), gt);
            float o[8];
#pragma unroll
            for (int i = 0; i < 4; ++i) { o[i] = sigmoidf_(gt[i]) * v0[i]; o[4 + i] = sigmoidf_(gt[4 + i]) * v1[i]; }
            bf16_t* mp = MB + (size_t)row * D + c8;
            if (MODE != 0) { float a[8]; unpack8(*(const u32x4*)mp, a);
#pragma unroll
                for (int i = 0; i < 8; ++i) o[i] += a[i]; }
            *(u32x4*)mp = pack8(o);
        EPI_END
    }
};
struct EpiResid {
    const float* res; float* out;
    DEV void operator()(const f32x4 (&acc)[2][2][4][2], const Unit& u, int wr, int wc, int fr, int fq) const {
        EPI_ROWS_BEGIN EPI_COLS_BEGIN
            const float* rp = res + (size_t)row * D + c8; float* op = out + (size_t)row * D + c8;
            const f32x4 r0 = *(const f32x4*)rp, r1 = *(const f32x4*)(rp + 4);
            *(f32x4*)op = r0 + v0; *(f32x4*)(op + 4) = r1 + v1;
        EPI_END
    }
};

template <class Epi> DEV void run_gemm_c(unsigned char* shm, int wv, const bf16_t* A, const bf16_t* Bt, int M, int N, int K, const Epi& E, int c) {
    pg8::Gemm g; g.A = A; g.Bt = Bt; g.M = M; g.N = N; g.K = K;
    pg8::StaticOrder So; So.init(M, N, (int)gridDim.x, c);
    pg8::gemm_phase<Epi>((LAS unsigned char*)shm, g, So, E, wv);
}
template <class Epi> DEV void run_gemm(unsigned char* shm, int wv, const bf16_t* A, const bf16_t* Bt, int M, int N, int K, const Epi& E) {
    pg8::Gemm g; g.A = A; g.Bt = Bt; g.M = M; g.N = N; g.K = K;
    pg8::StaticOrder So; So.init(M, N, (int)gridDim.x, (int)blockIdx.x);
    pg8::gemm_phase<Epi>((LAS unsigned char*)shm, g, So, E, wv);
}

DEV void convT(const float* __restrict__ src, int K, int N, bf16_t* __restrict__ dst, int Npad, unsigned char* shm, int wv) {
    float* tile = (float*)shm;
    const int tid = opaque_tid(wv), tk = K / 64, tn = Npad / 64, nt = tk * tn, G = (int)gridDim.x;
    for (int t = blockIdx.x; t < nt; t += 4 * G) {
        __syncthreads();
        float v[4][8];
#pragma unroll
        for (int q = 0; q < 4; ++q) { const int tt = t + q * G;
            if (tt < nt) { const int n0 = (tt % tn) * 64, k0 = (tt / tn) * 64;
#pragma unroll
                for (int i = 0; i < 8; ++i) { const int k = i * 8 + (tid >> 6), n = tid & 63; v[q][i] = (n0 + n < N) ? src[(size_t)(k0 + k) * N + n0 + n] : 0.f; } } }
#pragma unroll
        for (int q = 0; q < 4; ++q) { const int tt = t + q * G;
            if (tt < nt) {
#pragma unroll
                for (int i = 0; i < 8; ++i) { const int k = i * 8 + (tid >> 6), n = tid & 63; tile[q * 4160 + k * 65 + n] = v[q][i]; } } }
        __syncthreads();
        const int n = tid >> 3, ks = (tid & 7) * 8;
#pragma unroll
        for (int q = 0; q < 4; ++q) { const int tt = t + q * G;
            if (tt < nt) { const int n0 = (tt % tn) * 64, k0 = (tt / tn) * 64;
                float f[8];
#pragma unroll
                for (int j = 0; j < 8; ++j) f[j] = tile[q * 4160 + (ks + j) * 65 + n];
                *(u32x4*)(dst + (size_t)(n0 + n) * K + k0 + ks) = pack8(f); } }
    }
    __syncthreads();
}

DEV void rmsnorm_bf16(const float* x, const float* g, bf16_t* out, int rows, int wv, int blk0, int nblk) {
    const int tid_ = opaque_tid(wv), lane = tid_ & 63, wid = tid_ >> 6;
    for (int r = ((int)blockIdx.x - blk0) * 8 + wid; r < rows; r += nblk * 8) {
        const f32x4* xr = (const f32x4*)(x + (size_t)r * D);
        f32x4 v[8]; float ss = 0.f;
#pragma unroll
        for (int j = 0; j < 8; ++j) { v[j] = xr[j * 64 + lane]; ss += v[j][0] * v[j][0] + v[j][1] * v[j][1] + v[j][2] * v[j][2] + v[j][3] * v[j][3]; }
        ss = wave_sum_f(ss, lane);
        const float rstd = rsqrtf(ss * (1.f / D) + 1e-6f);
#pragma unroll
        for (int j = 0; j < 8; ++j) { const f32x4 gg = ((const f32x4*)g)[j * 64 + lane];
            u32x2 o; o[0] = cvt_pk_bf16(v[j][0] * rstd * gg[0], v[j][1] * rstd * gg[1]); o[1] = cvt_pk_bf16(v[j][2] * rstd * gg[2], v[j][3] * rstd * gg[3]);
            *(u32x2*)(out + (size_t)r * D + (j * 64 + lane) * 4) = o; }
    }
}
DEV void rmsnorm_f32_inplace(float* x, const float* g, int rows, int wv) {
    const int tid_ = opaque_tid(wv), lane = tid_ & 63, wid = tid_ >> 6;
    for (int r = blockIdx.x * 8 + wid; r < rows; r += gridDim.x * 8) {
        f32x4* xr = (f32x4*)(x + (size_t)r * D);
        f32x4 v[8]; float ss = 0.f;
#pragma unroll
        for (int j = 0; j < 8; ++j) { v[j] = xr[j * 64 + lane]; ss += v[j][0] * v[j][0] + v[j][1] * v[j][1] + v[j][2] * v[j][2] + v[j][3] * v[j][3]; }
        ss = wave_sum_f(ss, lane);
        const float rstd = rsqrtf(ss * (1.f / D) + 1e-6f);
#pragma unroll
        for (int j = 0; j < 8; ++j) { const f32x4 gg = ((const f32x4*)g)[j * 64 + lane]; xr[j * 64 + lane] = v[j] * rstd * gg; }
    }
}

DEV void ssm_coef(const Params& p, int l, int g, int n, float& abr, float& abi, float (&Br)[16], float (&Bi)[16]) {
    const int gi = l * 32 + g;
    const float are = p.in[5][gi * 64 + n], aim = p.in[6][gi * 64 + n], dt = expf(p.in[7][gi]);
    const float mag = expf(dt * are); float sn, cs; sincos_acc(dt * aim, sn, cs);
    abr = mag * cs; abi = mag * sn;
    const float nr = abr - 1.f, ni = abi, den = are * are + aim * aim;
    const float qr = (nr * are + ni * aim) / den, qi = (ni * are - nr * aim) / den;
    const float* bre = p.in[8] + (size_t)(gi * 64 + n) * 16; const float* bim = p.in[9] + (size_t)(gi * 64 + n) * 16;
#pragma unroll
    for (int q = 0; q < 16; ++q) { const float br = bre[q], bi = bim[q]; Br[q] = qr * br - qi * bi; Bi[q] = qr * bi + qi * br; }
}
DEV void load_u16(const bf16_t* ptr, float (&u)[16]) {
    const u32x4 a = *(const u32x4*)ptr, b = *(const u32x4*)(ptr + 8);
#pragma unroll
    for (int i = 0; i < 4; ++i) { u[2 * i] = bf_lo(a[i]); u[2 * i + 1] = bf_hi(a[i]); u[8 + 2 * i] = bf_lo(b[i]); u[8 + 2 * i + 1] = bf_hi(b[i]); }
}
DEV void ssm_stage_u(const bf16_t* P, int g, int c, int lane, bf16_t* us) {
    wave_mem_sync();
#pragma unroll
    for (int j = 0; j < 2; ++j) { const int tt = 2 * lane + j; const bf16_t* src = P + (size_t)(c * 128 + tt) * NINP + C_SSMU + g * 16;
        const u32x4 a = *(const u32x4*)src, b = *(const u32x4*)(src + 8); *(u32x4*)(us + tt * 16) = a; *(u32x4*)(us + tt * 16 + 8) = b; }
    wave_mem_sync();
}
DEV void ssm_pass1(const Params& p, int l, const bf16_t* P, float* XEND, int g, int c, int lane, bf16_t* us) {
    ssm_stage_u(P, g, c, lane, us);
    float abr, abi, Br[16], Bi[16]; ssm_coef(p, l, g, lane, abr, abi, Br, Bi);
    float xr = 0.f, xi = 0.f;
#pragma unroll 4
    for (int tt = 0; tt < 128; ++tt) {
        float u[16]; load_u16(us + tt * 16, u);
        float br = 0.f, bi = 0.f;
#pragma unroll
        for (int q = 0; q < 16; ++q) { br += Br[q] * u[q]; bi += Bi[q] * u[q]; }
        const float nr = abr * xr - abi * xi + br, ni = abr * xi + abi * xr + bi; xr = nr; xi = ni;
    }
    float* xe = XEND + ((size_t)(g * 64 + c) * 64 + lane) * 2; xe[0] = xr; xe[1] = xi;
}
DEV void ssm_pass2(const Params& p, int l, const bf16_t* P, const float* XEND, bf16_t* Z, int g, int c, int lane, bf16_t* us) {
    ssm_stage_u(P, g, c, lane, us);
    unsigned* xs = (unsigned*)(us + 128 * 16);
    float abr, abi, Br[16], Bi[16]; ssm_coef(p, l, g, lane, abr, abi, Br, Bi);
    const int gi = l * 32 + g, fr = lane & 15, fq = lane >> 4;
    bf16x8 Ca[4];
#pragma unroll
    for (int s4 = 0; s4 < 4; ++s4) {
        const int n0 = 16 * s4 + 4 * fq;
        const f32x4 cr = *(const f32x4*)(p.in[10] + (size_t)(gi * 16 + fr) * 64 + n0), ci = *(const f32x4*)(p.in[11] + (size_t)(gi * 16 + fr) * 64 + n0);
        u32x4 pk;
#pragma unroll
        for (int i = 0; i < 4; ++i) pk[i] = cvt_pk_bf16(cr[i], -ci[i]);
        Ca[s4] = __builtin_bit_cast(bf16x8, pk);
    }
    const f32x4 dsk = *(const f32x4*)(p.in[12] + l * 512 + g * 16 + 4 * fq);
    float pr = abr, pi = abi;
#pragma unroll
    for (int i = 0; i < 7; ++i) { const float nr = pr * pr - pi * pi, ni = 2.f * pr * pi; pr = nr; pi = ni; }
    float xr = 0.f, xi = 0.f;
    for (int cc = 0; cc < c; ++cc) { const float* xe = XEND + ((size_t)(g * 64 + cc) * 64 + lane) * 2; const float er = xe[0], ei = xe[1];
        const float nr = pr * xr - pi * xi + er, ni = pr * xi + pi * xr + ei; xr = nr; xi = ni; }
    for (int tb = 0; tb < 8; ++tb) {
#pragma unroll 4
        for (int t16 = 0; t16 < 16; ++t16) {
            const int tt = tb * 16 + t16;
            float u[16]; load_u16(us + tt * 16, u);
            float br0 = 0.f, bi0 = 0.f, br1 = 0.f, bi1 = 0.f;
#pragma unroll
            for (int q = 0; q < 8; ++q) { br0 += Br[q] * u[q]; bi0 += Bi[q] * u[q]; br1 += Br[8 + q] * u[8 + q]; bi1 += Bi[8 + q] * u[8 + q]; }
            const float nr = abr * xr - abi * xi + (br0 + br1), ni = abr * xi + abi * xr + (bi0 + bi1); xr = nr; xi = ni;
            xs[t16 * 64 + lane] = cvt_pk_bf16(xr, xi);
        }
        wave_mem_sync();
        f32x4 acc = (f32x4){0.f, 0.f, 0.f, 0.f};
#pragma unroll
        for (int s4 = 0; s4 < 4; ++s4) { const bf16x8 xb = *(const bf16x8*)(xs + fr * 64 + 16 * s4 + 4 * fq); acc = __builtin_amdgcn_mfma_f32_16x16x32_bf16(Ca[s4], xb, acc, 0, 0, 0); }
        const u32x2 uu = *(const u32x2*)(us + (tb * 16 + fr) * 16 + 4 * fq);
        const float y0 = acc[0] + dsk[0] * bf_lo(uu[0]), y1 = acc[1] + dsk[1] * bf_hi(uu[0]), y2 = acc[2] + dsk[2] * bf_lo(uu[1]), y3 = acc[3] + dsk[3] * bf_hi(uu[1]);
        u32x2 zz; zz[0] = cvt_pk_bf16(gelu_tanh(y0), gelu_tanh(y1)); zz[1] = cvt_pk_bf16(gelu_tanh(y2), gelu_tanh(y3));
        *(u32x2*)(Z + (size_t)(c * 128 + tb * 16 + fr) * 512 + g * 16 + 4 * fq) = zz;
        wave_mem_sync();
    }
}

template <int NR>
DEV int count_ge_all(const unsigned (&key)[NR], unsigned cand) {
    int c0 = 0, c1 = 0, c2 = 0, c3 = 0;
#pragma unroll
    for (int j = 0; j < NR; j += 4) {
        unsigned long long m0, m1, m2, m3;
        asm volatile("s_nop 1\n\t"
                     "v_cmp_le_u32_e64 %[m0], %[cand], %[k0]\n\t"
                     "v_cmp_le_u32_e64 %[m1], %[cand], %[k1]\n\t"
                     "v_cmp_le_u32_e64 %[m2], %[cand], %[k2]\n\t"
                     "v_cmp_le_u32_e64 %[m3], %[cand], %[k3]\n\t"
                     "v_addc_co_u32_e64 %[c0], %[m0], 0, %[c0], %[m0]\n\t"
                     "v_addc_co_u32_e64 %[c1], %[m1], 0, %[c1], %[m1]\n\t"
                     "v_addc_co_u32_e64 %[c2], %[m2], 0, %[c2], %[m2]\n\t"
                     "v_addc_co_u32_e64 %[c3], %[m3], 0, %[c3], %[m3]"
                     : [c0] "+v"(c0), [c1] "+v"(c1), [c2] "+v"(c2), [c3] "+v"(c3), [m0] "=&s"(m0), [m1] "=&s"(m1), [m2] "=&s"(m2), [m3] "=&s"(m3)
                     : [cand] "s"(cand), [k0] "v"(key[j]), [k1] "v"(key[j + 1]), [k2] "v"(key[j + 2]), [k3] "v"(key[j + 3]));
    }
    return (c0 + c1) + (c2 + c3);
}
template <int NR>
DEV void select_topk(const float* __restrict__ sc, int t, int lane, int* __restrict__ idx_out) {
    asm volatile("" : "+v"(lane));
    unsigned key[NR];
    const int nr = (t >> 6) + 1;
#pragma unroll
    for (int j = 0; j < NR; ++j) { unsigned u = 0u;
        if (j < nr) { u = __float_as_uint(sc[j * 64 + lane]); u = (u & 0x80000000u) ? ~u : (u | 0x80000000u); }
        key[j] = u; }
    unsigned thr = 0u;
    for (int bit = 31; bit >= 0; --bit) {
        const unsigned cand = __builtin_amdgcn_readfirstlane(thr | (1u << bit));
        int c = count_ge_all<NR>(key, cand);
        c = __builtin_amdgcn_readfirstlane(wave_sum_i(c));
        if (c >= 256) { thr = cand; if (c == 256) break; }
    }
    int cgt = 0;
    { const unsigned thr1 = __builtin_amdgcn_readfirstlane(thr + 1u);
      cgt = count_ge_all<NR>(key, thr1); }
    cgt = __builtin_amdgcn_readfirstlane(wave_sum_i(cgt));
    int need = 256 - cgt, base = 0;
#pragma unroll
    for (int j = 0; j < NR; ++j) {
        const bool gt = key[j] > thr, eq = key[j] == thr;
        const unsigned long long meq = __ballot(eq);
        const int peq = (int)__builtin_amdgcn_mbcnt_hi((unsigned)(meq >> 32), __builtin_amdgcn_mbcnt_lo((unsigned)meq, 0u));
        const bool take = gt || (eq && peq < need);
        const int neq = __popcll(meq); need = (need > neq) ? need - neq : 0;
        const unsigned long long mt = __ballot(take);
        const int pos = base + (int)__builtin_amdgcn_mbcnt_hi((unsigned)(mt >> 32), __builtin_amdgcn_mbcnt_lo((unsigned)mt, 0u));
        if (take && pos < 256) idx_out[pos] = j * 64 + lane;
        base += __popcll(mt);
        __builtin_amdgcn_sched_barrier(0);
    }
}
DEV void indexer_task(const bf16_t* P, int t0, float* sc, int* IDX, int lane, void* kbuf  ) {
    int ln = lane; asm volatile("" : "+v"(ln));
    const int hh = ln >> 5, r = ln & 31;
    const int jj = r >> 3, hb = (r >> 2) & 1, ii = r & 3;
    const int qa = 2 * hb + (jj >> 1), ha = 4 * (jj & 1) + ii;
    bf16x8 afr[4];
    { const bf16_t* ap = P + (size_t)(t0 + qa) * NINP + C_QI + ha * 64 + 8 * hh;
#pragma unroll
      for (int kk = 0; kk < 4; ++kk) afr[kk] = *(const bf16x8*)(ap + 16 * kk); }
    float w0[8], w1[8];
    unpack8(*(const u32x4*)(P + (size_t)(t0 + 2 * hh) * NINP + C_WI), w0);
    unpack8(*(const u32x4*)(P + (size_t)(t0 + 2 * hh + 1) * NINP + C_WI), w1);
    const int ngrp = ((t0 + 3) >> 6) + 1;
    const int tq0 = t0 + 2 * hh, tq1 = tq0 + 1;
    const float ninf = -__builtin_huge_valf();
    unsigned char* kb = (unsigned char*)kbuf;
    const int lrow = ln >> 3, lch = ln & 7;
#define IDX_FETCH(regs, g) do { _Pragma("unroll") for (int i = 0; i < 8; ++i) regs[i] = *(const u32x4*)(P + (size_t)((g) * 64 + i * 8 + lrow) * NINP + C_KI + lch * 8); } while (0)
#define IDX_PARK(regs, bsel) do { _Pragma("unroll") for (int i = 0; i < 8; ++i) { const int kl = i * 8 + lrow; \
        *(u32x4*)(kb + (bsel) * 8192 + kl * 128 + ((lch ^ (kl & 7)) << 4)) = regs[i]; } } while (0)
#define IDX_SCORE(bsel, g) do { _Pragma("unroll") for (int u = 0; u < 2; ++u) { const int s = (g) * 64 + u * 32 + r; const int kl = u * 32 + r; f32x16 acc; \
        _Pragma("unroll") for (int i = 0; i < 16; ++i) acc[i] = 0.f; \
        _Pragma("unroll") for (int kk = 0; kk < 4; ++kk) { const bf16x8 bv = *(const bf16x8*)(kb + (bsel) * 8192 + kl * 128 + (((2 * kk + hh) ^ (kl & 7)) << 4)); \
            acc = __builtin_amdgcn_mfma_f32_32x32x16_bf16(afr[kk], bv, acc, 0, 0, 0); } \
        float s0 = 0.f, s1 = 0.f; \
        _Pragma("unroll") for (int j = 0; j < 8; ++j) { s0 += w0[j] * fmaxf(acc[j], 0.f); s1 += w1[j] * fmaxf(acc[8 + j], 0.f); } \
        sc[(size_t)(2 * hh) * 8192 + s] = (s <= tq0) ? s0 : ninf; sc[(size_t)(2 * hh + 1) * 8192 + s] = (s <= tq1) ? s1 : ninf; } } while (0)
    u32x4 kreg[8];
    wave_mem_sync();
    IDX_FETCH(kreg, 0); IDX_PARK(kreg, 0);
    wave_mem_sync();
    for (int grp = 0; grp < ngrp; ++grp) {
        const int g1 = (grp + 1 < ngrp) ? grp + 1 : grp;
        IDX_FETCH(kreg, g1);
        IDX_SCORE(grp & 1, grp);
        IDX_PARK(kreg, (grp + 1) & 1);
        wave_mem_sync();
    }
#undef IDX_FETCH
#undef IDX_PARK
#undef IDX_SCORE
    asm volatile("s_waitcnt vmcnt(0)" ::: "memory");
    wave_mem_sync();
    for (int qq = 0; qq < 4; ++qq) {
        const int t = t0 + qq;
        if (t < 256) continue;
        const int nr = (t >> 6) + 1;
        const float* scq = sc + (size_t)qq * 8192; int* io = IDX + (size_t)t * 256;
        if (nr <= 32) select_topk<32>(scq, t, lane, io);
        else if (nr <= 64) select_topk<64>(scq, t, lane, io);
        else if (nr <= 96) select_topk<96>(scq, t, lane, io);
        else select_topk<128>(scq, t, lane, io);
    }
}

typedef __bf16 bf16x2_t __attribute__((ext_vector_type(2)));
DEV float dot2bf(unsigned a, unsigned b, float c) { return __builtin_amdgcn_fdot2_f32_bf16(__builtin_bit_cast(bf16x2_t, a), __builtin_bit_cast(bf16x2_t, b), c, false); }
DEV void attn_query(const bf16_t* P, const int* IDX, bf16_t* YC, int t, int lane, float* lg, int* ids) {
    const int nk = (t < 255) ? t + 1 : 256;
    wave_mem_sync();
#pragma unroll
    for (int j = 0; j < 4; ++j) { const int k = lane + 64 * j; ids[k] = (t < 256) ? ((k <= t) ? k : 0) : IDX[(size_t)t * 256 + k]; }
    wave_mem_sync();
    const int fr = lane & 15, fq = lane >> 4;
    {
        bf16x8 bq[4][2];
#pragma unroll
        for (int g = 0; g < 4; ++g)
#pragma unroll
            for (int kk = 0; kk < 2; ++kk) {
                if (fr < 4) bq[g][kk] = *(const bf16x8*)(P + (size_t)t * NINP + C_Q + (4 * g + fr) * 64 + 32 * kk + 8 * fq);
                else bq[g][kk] = (bf16x8){0, 0, 0, 0, 0, 0, 0, 0};
            }
        const int ntile = (nk + 15) >> 4;
        bf16x8 acur[4][2];
        { const bf16_t* kp = P + (size_t)ids[fr] * NINP + C_K + 8 * fq;
#pragma unroll
          for (int g = 0; g < 4; ++g)
#pragma unroll
              for (int kk = 0; kk < 2; ++kk) acur[g][kk] = *(const bf16x8*)(kp + 64 * g + 32 * kk); }
        for (int tl = 0; tl < ntile; ++tl) {
            const int tn = (tl + 1 < ntile) ? tl + 1 : tl;
            const bf16_t* kp = P + (size_t)ids[tn * 16 + fr] * NINP + C_K + 8 * fq;
            bf16x8 anxt[4][2];
#pragma unroll
            for (int g = 0; g < 4; ++g)
#pragma unroll
                for (int kk = 0; kk < 2; ++kk) anxt[g][kk] = *(const bf16x8*)(kp + 64 * g + 32 * kk);
#pragma unroll
            for (int g = 0; g < 4; ++g) {
                f32x4 acc = (f32x4){0.f, 0.f, 0.f, 0.f};
                acc = __builtin_amdgcn_mfma_f32_16x16x32_bf16(acur[g][0], bq[g][0], acc, 0, 0, 0);
                acc = __builtin_amdgcn_mfma_f32_16x16x32_bf16(acur[g][1], bq[g][1], acc, 0, 0, 0);
                if (fr < 4) {
                    const int kp0 = tl * 8 + 2 * fq, hd = 4 * g + fr;
                    *(f32x2_t*)(lg + (kp0 * 16 + hd) * 2) = (f32x2_t){acc[0] * 0.125f, acc[1] * 0.125f};
                    *(f32x2_t*)(lg + ((kp0 + 1) * 16 + hd) * 2) = (f32x2_t){acc[2] * 0.125f, acc[3] * 0.125f};
                }
            }
#pragma unroll
            for (int g = 0; g < 4; ++g)
#pragma unroll
                for (int kk = 0; kk < 2; ++kk) acur[g][kk] = anxt[g][kk];
        }
    }
    wave_mem_sync();
    {
        const int h = lane & 15, kq = lane >> 4;
        float v[64]; float mx = -3.0e38f;
#pragma unroll
        for (int j = 0; j < 32; ++j) { const int kp = 4 * j + kq; const f32x2_t x = *(const f32x2_t*)(lg + (kp * 16 + h) * 2);
            v[2 * j] = (2 * kp < nk) ? x[0] : -3.0e38f; v[2 * j + 1] = (2 * kp + 1 < nk) ? x[1] : -3.0e38f; mx = fmaxf(mx, fmaxf(v[2 * j], v[2 * j + 1])); }
        mx = fmaxf(mx, shx(mx, 16, lane)); mx = fmaxf(mx, shx(mx, 32, lane));
        float sm = 0.f;
#pragma unroll
        for (int j = 0; j < 32; ++j) { const int kp = 4 * j + kq;
            v[2 * j] = (2 * kp < nk) ? __expf(v[2 * j] - mx) : 0.f; v[2 * j + 1] = (2 * kp + 1 < nk) ? __expf(v[2 * j + 1] - mx) : 0.f; sm += v[2 * j] + v[2 * j + 1]; }
        sm += shx(sm, 16, lane); sm += shx(sm, 32, lane);
        const float inv = 1.f / sm;
        wave_mem_sync();
        unsigned* pP = (unsigned*)lg;
#pragma unroll
        for (int j = 0; j < 32; ++j) { const int kp = 4 * j + kq; pP[kp * 16 + h] = cvt_pk_bf16(v[2 * j] * inv, v[2 * j + 1] * inv); }
    }
    wave_mem_sync();
    {
        const unsigned* pP = (const unsigned*)lg;
        const int ks = lane >> 5, dq = lane & 31, g = dq >> 3;
        float o[4][8];
#pragma unroll
        for (int r = 0; r < 4; ++r)
#pragma unroll
            for (int i = 0; i < 8; ++i) o[r][i] = 0.f;
        const int nit = (((nk + 1) >> 1) + 1) >> 1, ngrp = (nit + 3) >> 2;
#define PV_LOAD(A, B, grp) do { _Pragma("unroll") for (int u = 0; u < 4; ++u) { const int kp = 2 * ((grp) * 4 + u) + ks; const int2_t rr = *(const int2_t*)(ids + 2 * kp); \
            A[u] = *(const u32x4*)(P + (size_t)rr[0] * NINP + C_V + 8 * dq); B[u] = *(const u32x4*)(P + (size_t)rr[1] * NINP + C_V + 8 * dq); } } while (0)
#define PV_ACC(A, B, grp) do { _Pragma("unroll") for (int u = 0; u < 4; ++u) { const int kp = 2 * ((grp) * 4 + u) + ks; const u32x4 pp = *(const u32x4*)(pP + kp * 16 + 4 * g); \
            _Pragma("unroll") for (int i = 0; i < 4; ++i) { const unsigned ev = __builtin_amdgcn_perm(B[u][i], A[u][i], 0x05040100u), od = __builtin_amdgcn_perm(B[u][i], A[u][i], 0x07060302u); \
                _Pragma("unroll") for (int r = 0; r < 4; ++r) { o[r][2 * i] = dot2bf(ev, pp[r], o[r][2 * i]); o[r][2 * i + 1] = dot2bf(od, pp[r], o[r][2 * i + 1]); } } } } while (0)
        u32x4 ra[4], rb[4], na[4], nb[4];
        PV_LOAD(ra, rb, 0);
        for (int grp = 0; grp < ngrp; grp += 2) {
            { const int g1 = (grp + 1 < ngrp) ? grp + 1 : grp; PV_LOAD(na, nb, g1); }
            PV_ACC(ra, rb, grp);
            if (grp + 1 < ngrp) {
                { const int g2 = (grp + 2 < ngrp) ? grp + 2 : grp + 1; PV_LOAD(ra, rb, g2); }
                PV_ACC(na, nb, grp + 1);
            }
        }
#undef PV_LOAD
#undef PV_ACC
#pragma unroll
        for (int r = 0; r < 4; ++r)
#pragma unroll
            for (int i = 0; i < 8; ++i) o[r][i] += shx(o[r][i], 32, lane);
        if (ks == 0) {
#pragma unroll
            for (int r = 0; r < 4; ++r) *(u32x4*)(YC + (size_t)t * 1024 + (4 * g + r) * 64 + 8 * (dq & 7)) = pack8(o[r]);
        }
    }
}

#define XB_TMO      128
#define XB_XCNT(j)  (256  + 64 * (j))
#define XB_XSUB(j)  (1280 + 64 * (j))
#define XB_XGEN(j)  (2304 + 64 * (j))
#define XB_TOP      3328
#define XB_TOPGEN   3392
#define XCD_BAR_WORDS 3456
#define XB_SPIN_CAP (1u << 22)
DEV unsigned xb_ld(unsigned* p)              { return __hip_atomic_load(p, __ATOMIC_RELAXED, __HIP_MEMORY_SCOPE_AGENT); }
DEV unsigned xb_add(unsigned* p, unsigned v) { return __hip_atomic_fetch_add(p, v, __ATOMIC_RELAXED, __HIP_MEMORY_SCOPE_AGENT); }
DEV unsigned xb_xcc_id() { return (unsigned)__builtin_amdgcn_s_getreg((3 << 11) | 20) & 0xFu; }
#define XB_SPIN(cond, bar) do { unsigned _sp = 0; while (cond) { __builtin_amdgcn_s_sleep(1); \
    if ((++_sp & 255u) == 0u) { if (xb_ld(&(bar)[XB_TMO])) break; if (_sp > XB_SPIN_CAP) { atomicAdd(&(bar)[XB_TMO], 1u); break; } } } } while (0)
struct XcdBarrier { unsigned* bar; unsigned x; volatile LAS unsigned* st; };
DEV void xcd_barrier_complete(unsigned* bar, unsigned x, unsigned& nloc, unsigned& nx) {
    const unsigned G = gridDim.x;
    unsigned sum, cnt, mine, sp = 0u;
    for (;;) {
        sum = 0u; cnt = 0u; mine = 0u;
#pragma unroll
        for (unsigned j = 0; j < 16; ++j) { const unsigned c = xb_ld(&bar[XB_XCNT(j)]); sum += c; cnt += (c > 0u) ? 1u : 0u; mine = (j == x) ? c : mine; }
        if (sum == G) break;
        __builtin_amdgcn_s_sleep(1);
        if ((++sp & 255u) == 0u) { if (xb_ld(&bar[XB_TMO])) break; if (sp > XB_SPIN_CAP) { atomicAdd(&bar[XB_TMO], 1u); break; } }
    }
    nloc = mine > 0u ? mine : 1u; nx = cnt > 0u ? cnt : 1u;
}
DEV void xcd_barrier(const XcdBarrier& b, int wv) {
    asm volatile("s_waitcnt vmcnt(0)" ::: "memory");
    __syncthreads();
    if (opaque_tid(wv) == 0) {
        unsigned* bar = b.bar;
        __builtin_amdgcn_s_waitcnt(0);
        unsigned nloc = b.st[0], nx = b.st[1];
        if (nloc == 0u) { xcd_barrier_complete(bar, b.x, nloc, nx); b.st[0] = nloc; b.st[1] = nx; }
        const unsigned old = xb_add(&bar[XB_XSUB(b.x)], 1u);
        const unsigned gen = old / nloc;
        if (old + 1u == (gen + 1u) * nloc) {
            __builtin_amdgcn_fence(__ATOMIC_RELEASE, "agent");
            asm volatile("s_waitcnt vmcnt(0)" ::: "memory");
            const unsigned og = xb_add(&bar[XB_TOP], 1u);
            const unsigned tg = og / nx;
            if (og + 1u == (tg + 1u) * nx) xb_add(&bar[XB_TOPGEN], 1u);
            else XB_SPIN(xb_ld(&bar[XB_TOPGEN]) == tg, bar);
            __builtin_amdgcn_fence(__ATOMIC_ACQUIRE, "agent");
            xb_add(&bar[XB_XGEN(b.x)], 1u);
            asm volatile("s_waitcnt vmcnt(0)" ::: "memory");
        } else {
            XB_SPIN(xb_ld(&bar[XB_XGEN(b.x)]) == gen, bar);
            __builtin_amdgcn_fence(__ATOMIC_ACQUIRE, "agent");
            asm volatile("s_waitcnt vmcnt(0)" ::: "memory");
        }
    }
    __syncthreads();
}

#ifndef PROBE_PHASE
#define PROBE_PHASE -1
#endif
#define TSTART(k) if (PROBE_PHASE == (k)) t0 = (unsigned)__builtin_amdgcn_s_memrealtime();
#define TEND(k) if (PROBE_PHASE == (k)) tacc += (unsigned)__builtin_amdgcn_s_memrealtime() - t0;
__global__ __launch_bounds__(512, 2) void fwd_megakernel(Params p) {
    extern __shared__ __attribute__((aligned(16))) unsigned char shm[];
    cg::grid_group grid = cg::this_grid();
    const int wv = __builtin_amdgcn_readfirstlane((int)threadIdx.x >> 6);
#define PHASE_IDS const int tid = opaque_tid(wv), lane = tid & 63, wid = __builtin_amdgcn_readfirstlane(tid >> 6); const int gw = blockIdx.x * 8 + wid, nw = gridDim.x * 8; const int gt = blockIdx.x * 512 + tid, nthr = gridDim.x * 512; (void)lane; (void)gw; (void)nw; (void)gt; (void)nthr;
    unsigned char* ws = p.ws;
    unsigned t0 = 0, tacc = 0; (void)t0; (void)tacc;
    XcdBarrier xb; xb.bar = (unsigned*)(ws + WS_BAR); xb.x = xb_xcc_id(); xb.st = (volatile LAS unsigned*)(LAS unsigned char*)(shm + 8 * WAVE_LDS);
    if (opaque_tid(wv) == 0) { xb.st[0] = 0u; xb.st[1] = 0u; (void)xb_add(&xb.bar[XB_XCNT(xb.x)], 1u); }
    __syncthreads();
    TSTART(0)
    float* CT = (float*)(ws + WS_CT); float* ST = (float*)(ws + WS_ST);
    bf16_t* H0 = (bf16_t*)(ws + WS_H); bf16_t* H1 = (bf16_t*)(ws + WS_H2); bf16_t* P = (bf16_t*)(ws + WS_P);
    bf16_t* YA = (bf16_t*)(ws + WS_YA); bf16_t* YB = (bf16_t*)(ws + WS_YB); bf16_t* Z = (bf16_t*)(ws + WS_Z); bf16_t* YC = (bf16_t*)(ws + WS_YC);
    bf16_t* MB = (bf16_t*)(ws + WS_MB); int* IDX = (int*)(ws + WS_IDX); float* XEND = (float*)(ws + WS_XEND);
    bf16_t* UP = (bf16_t*)(ws + WS_UP); bf16_t* ACT = (bf16_t*)(ws + WS_ACT); float* SC = (float*)(ws + WS_SC); float* MF = (float*)(ws + WS_MF);

    for (int l = 0; l < 2; ++l) {
        unsigned char* wl = ws + WS_W + (size_t)l * WL_SIZE;
        convT(p.in[3] + (size_t)l * D * NIN, D, NIN, (bf16_t*)(wl + WL_WIN), NINP, shm, wv);
        convT(p.in[14] + (size_t)l * 512 * D, 512, D, (bf16_t*)(wl + WL_WA), D, shm, wv);
        convT(p.in[15] + (size_t)l * 512 * D, 512, D, (bf16_t*)(wl + WL_WB), D, shm, wv);
        convT(p.in[16] + (size_t)l * 1024 * D, 1024, D, (bf16_t*)(wl + WL_WC), D, shm, wv);
        convT(p.in[13] + (size_t)l * 512 * 512, 512, 512, (bf16_t*)(wl + WL_WGLU), 512, shm, wv);
        convT(p.in[17] + (size_t)l * D * D, D, D, (bf16_t*)(wl + WL_WOUT), D, shm, wv);
        convT(p.in[19] + (size_t)l * D * DFF2, D, DFF2, (bf16_t*)(wl + WL_WUP), DFF2, shm, wv);
        convT(p.in[21] + (size_t)l * DFF * D, DFF, D, (bf16_t*)(wl + WL_WDOWN), D, shm, wv);
    }
    {
        PHASE_IDS
        const int* pos = (const int*)p.in[1];
        for (int i = gt; i < NB * S * 8; i += nthr) { const float ang = (float)pos[i >> 3] * p.inv_freq[i & 7]; float sn, cs; sincos_acc(ang, sn, cs); CT[i] = cs; ST[i] = sn; }
    }
    grid.sync();
    TEND(0)

    for (int l = 0; l < 2; ++l) {
        const unsigned char* wl = ws + WS_W + (size_t)l * WL_SIZE;
        const bf16_t* WinT = (const bf16_t*)(wl + WL_WIN); const bf16_t* WaT = (const bf16_t*)(wl + WL_WA); const bf16_t* WbT = (const bf16_t*)(wl + WL_WB);
        const bf16_t* WcT = (const bf16_t*)(wl + WL_WC); const bf16_t* WgluT = (const bf16_t*)(wl + WL_WGLU); const bf16_t* WoutT = (const bf16_t*)(wl + WL_WOUT);
        const bf16_t* WupT = (const bf16_t*)(wl + WL_WUP); const bf16_t* WdownT = (const bf16_t*)(wl + WL_WDOWN);
        for (int b = 0; b < NB; ++b) {
            const float* xin = (l == 0) ? p.in[0] + (size_t)b * S * D : p.out + (size_t)b * S * D;
            float* xres = p.out + (size_t)b * S * D;
            const int itn = l * NB + b;
            bf16_t* H = (itn & 1) ? H1 : H0; bf16_t* Hn = (itn & 1) ? H0 : H1;
            TSTART(1)
            if (itn == 0) { rmsnorm_bf16(xin, p.in[2] + l * D, H, S, wv, 0, (int)gridDim.x); xcd_barrier(xb, wv); }
            TEND(1)
            TSTART(2)
            { EpiP E; E.P = P; E.ct = CT + (size_t)b * S * 8; E.st = ST + (size_t)b * S * 8; E.col0 = 0; run_gemm(shm, wv, H, WinT, S, NINP - 256, D, E); }
            xcd_barrier(xb, wv);
            TEND(2)
            TSTART(3)
            {
                PHASE_IDS
                TSTART(15)
                const float* cw = p.in[4] + l * 3 * 512;
                const bool heavy = (wid == 0) | (wid == 2) | (wid == 5) | (wid == 7);
                const int hq = (wid == 0) ? 0 : (wid == 2) ? 1 : (wid == 5) ? 2 : 3, lq = (wid == 1) ? 0 : (wid == 3) ? 1 : (wid == 4) ? 2 : 3;
                if (!heavy) for (int it = (int)blockIdx.x * 256 + lq * 64 + lane; it < S * 64; it += (int)gridDim.x * 256) {
                    const int t = it >> 6, c8 = (it & 63) * 8;
                    float a[8] = {0.f, 0.f, 0.f, 0.f, 0.f, 0.f, 0.f, 0.f};
#pragma unroll
                    for (int j = 0; j < 3; ++j) { const int tt = t - 2 + j; if (tt >= 0) {
                            float xx[8], cc[8]; unpack8(*(const u32x4*)(P + (size_t)tt * NINP + C_SCX + c8), xx); unpack8(*(const u32x4*)(P + (size_t)tt * NINP + C_SCC + c8), cc);
                            const f32x4 w0 = *(const f32x4*)(cw + j * 512 + c8), w1 = *(const f32x4*)(cw + j * 512 + c8 + 4);
#pragma unroll
                            for (int i = 0; i < 4; ++i) { a[i] += w0[i] * (cc[i] * xx[i]); a[4 + i] += w1[i] * (cc[4 + i] * xx[4 + i]); } } }
                    float bb[8]; unpack8(*(const u32x4*)(P + (size_t)t * NINP + C_SCB + c8), bb);
#pragma unroll
                    for (int i = 0; i < 8; ++i) a[i] *= bb[i];
                    *(u32x4*)(YA + (size_t)t * 512 + c8) = pack8(a);
                }
                TEND(15) TSTART(16)
                if (!heavy) for (int i = (int)blockIdx.x * 4 + lq; i < 2048; i += (int)gridDim.x * 4) ssm_pass1(p, l, P, XEND, i >> 6, i & 63, lane, (bf16_t*)(shm + wid * WAVE_LDS));
                TEND(16) TSTART(17)
                for (int i = gw; i < 2048; i += nw) {
                    const int bq = i >> 3; const int task = heavy ? 2047 - (bq * 4 + hq) : bq * 4 + lq;
                    indexer_task(P, task * 4, SC + (size_t)gw * 4 * 8192, IDX, lane, shm + wid * WAVE_LDS);
                }
                TEND(17)
            }
            xcd_barrier(xb, wv);
            TEND(3)
            TSTART(4)
            {
                PHASE_IDS
                TSTART(13)
                for (int i = gw; i < 2048; i += nw) ssm_pass2(p, l, P, XEND, Z, i >> 6, i & 63, lane, (bf16_t*)(shm + wid * WAVE_LDS));
                TEND(13) TSTART(14)
                float* lg = (float*)(shm + wid * WAVE_LDS); int* ids = (int*)(shm + wid * WAVE_LDS + 16384);
                if (gridDim.x == 256) {
                    const int xq = (int)(blockIdx.x & 7) * 1024 + (int)(blockIdx.x >> 3) * 8 + wid;
                    for (int j = 0; j < 4; ++j) attn_query(P, IDX, YC, xq + 256 * j, lane, lg, ids);
                } else for (int t = gw; t < S; t += nw) attn_query(P, IDX, YC, t, lane, lg, ids);
                TEND(14)
            }
            xcd_barrier(xb, wv);
            TEND(4)
            TSTART(5)
            { EpiGlu E; E.Z = Z; E.YB = YB; run_gemm(shm, wv, Z, WgluT, S, 512, 512, E); }
            if (gridDim.x >= 96 && blockIdx.x >= 64 && blockIdx.x < 96) { EpiP E; E.P = P; E.ct = CT + (size_t)b * S * 8; E.st = ST + (size_t)b * S * 8; E.col0 = NINP - 256; run_gemm_c(shm, wv, H, WinT + (size_t)(NINP - 256) * D, S, 256, D, E, (int)blockIdx.x - 64); }
            else if (gridDim.x < 96) { EpiP E; E.P = P; E.ct = CT + (size_t)b * S * 8; E.st = ST + (size_t)b * S * 8; E.col0 = NINP - 256; run_gemm(shm, wv, H, WinT + (size_t)(NINP - 256) * D, S, 256, D, E); }
            xcd_barrier(xb, wv);
            TEND(5)
            TSTART(6)
            { EpiMerge<0> E; E.G = P + C_GA; E.MF = MF; E.MB = MB; run_gemm(shm, wv, YA, WaT, S, D, 512, E); }
            { EpiMerge<1> E; E.G = P + C_GC; E.MF = MF; E.MB = MB; run_gemm(shm, wv, YC, WcT, S, D, 1024, E); }
            { EpiMerge<2> E; E.G = P + C_GB; E.MF = MF; E.MB = MB; run_gemm(shm, wv, YB, WbT, S, D, 512, E); }
            xcd_barrier(xb, wv);
            TEND(6)
            TSTART(7)
            { EpiResid E; E.res = xin; E.out = xres; run_gemm(shm, wv, MB, WoutT, S, D, D, E); }
            xcd_barrier(xb, wv);
            TEND(7)
            TSTART(8)
            rmsnorm_bf16(xres, p.in[18] + l * D, H, S, wv, 0, (int)gridDim.x);
            xcd_barrier(xb, wv);
            TEND(8)
            TSTART(9)
            { EpiStore E; E.O = UP; E.ldc = DFF2; run_gemm(shm, wv, H, WupT, S, DFF2, D, E); }
            if (itn != 2 * NB - 1) {
                const int ln_ = (b == NB - 1) ? l + 1 : l, bn_ = (b == NB - 1) ? 0 : b + 1;
                const float* xnext = (ln_ == 0) ? p.in[0] + (size_t)bn_ * S * D : p.out + (size_t)bn_ * S * D;
                if (gridDim.x == 256) { if (blockIdx.x >= 128) rmsnorm_bf16(xnext, p.in[2] + ln_ * D, Hn, S, wv, 128, 128); }
                else rmsnorm_bf16(xnext, p.in[2] + ln_ * D, Hn, S, wv, 0, (int)gridDim.x);
            }
            xcd_barrier(xb, wv);
            TEND(9)
            TSTART(10)
            {
                PHASE_IDS
                const float* fw = p.in[20] + (size_t)l * 3 * DFF2;
                const int nitem = 704 * (S / 8), nfull_trips = nitem / nthr, rem = nitem - nfull_trips * nthr;
                const bool split = (2 * rem == nthr);
                const int ntrip = split ? nfull_trips + 1 : (nitem + nthr - 1) / nthr;
                for (int trip = 0; trip < ntrip; ++trip) {
                    const bool half = split && (trip == nfull_trips);
                    const int it = half ? nfull_trips * nthr + (gt >> 1) : trip * nthr + gt;
                    if (it >= nitem) break;
                    const int ntok = half ? 4 : 8;
                    const int tc = it / 704, c8 = (it - tc * 704) * 8, t0 = tc * 8 + (half ? 4 * (gt & 1) : 0);
                    u32x4 rg[10], ru[10];
#pragma unroll
                    for (int j = 0; j < 10; ++j) { const int tt = t0 - 2 + j;
                        if (tt >= 0 && j < ntok + 2) { rg[j] = *(const u32x4*)(UP + (size_t)tt * DFF2 + c8); ru[j] = *(const u32x4*)(UP + (size_t)tt * DFF2 + DFF + c8); }
                        else { rg[j] = (u32x4){0u, 0u, 0u, 0u}; ru[j] = (u32x4){0u, 0u, 0u, 0u}; } }
                    float wg[3][8], wu[3][8];
#pragma unroll
                    for (int j = 0; j < 3; ++j) { const f32x4 g0 = *(const f32x4*)(fw + j * DFF2 + c8), g1 = *(const f32x4*)(fw + j * DFF2 + c8 + 4);
                        const f32x4 u0 = *(const f32x4*)(fw + j * DFF2 + DFF + c8), u1 = *(const f32x4*)(fw + j * DFF2 + DFF + c8 + 4);
#pragma unroll
                        for (int i = 0; i < 4; ++i) { wg[j][i] = g0[i]; wg[j][4 + i] = g1[i]; wu[j][i] = u0[i]; wu[j][4 + i] = u1[i]; } }
#pragma unroll
                    for (int r = 0; r < 8; ++r) { if (r < ntok) {
                        float G[8] = {0.f, 0.f, 0.f, 0.f, 0.f, 0.f, 0.f, 0.f}, U[8] = {0.f, 0.f, 0.f, 0.f, 0.f, 0.f, 0.f, 0.f};
#pragma unroll
                        for (int j = 0; j < 3; ++j) { float gg[8], uu[8]; unpack8(rg[r + j], gg); unpack8(ru[r + j], uu);
#pragma unroll
                            for (int i = 0; i < 8; ++i) { G[i] += wg[j][i] * gg[i]; U[i] += wu[j][i] * uu[i]; } }
                        float o[8];
#pragma unroll
                        for (int i = 0; i < 8; ++i) o[i] = G[i] * sigmoidf_(G[i]) * U[i];
                        *(u32x4*)(ACT + (size_t)(t0 + r) * DFF + c8) = pack8(o);
                    } }
                }
            }
            xcd_barrier(xb, wv);
            TEND(10)
            TSTART(11)
            { EpiResid E; E.res = xres; E.out = xres; run_gemm(shm, wv, ACT, WdownT, S, D, DFF, E); }
            xcd_barrier(xb, wv);
            TEND(11)
        }
    }
    TSTART(12)
    rmsnorm_f32_inplace(p.out, p.in[22], NB * S, wv);
    if (PROBE_PHASE >= 0) { xcd_barrier(xb, wv); TEND(12) if (blockIdx.x == 0 && opaque_tid(wv) == 256) p.out[0] = (float)tacc * 1e-3f; }
}

extern "C" void kernel_launch(void* const* d_in, const int* in_sizes, int n_in, void* d_out, int out_size, void* d_ws, size_t ws_size, hipStream_t stream) {
    static int grid_blocks = 0;
    if (!grid_blocks) {
        if (n_in != 23 || ws_size < WS_END) { fprintf(stderr, "kernel_launch: unexpected n_in %d or ws_size %zu < %zu\n", n_in, ws_size, (size_t)WS_END); grid_blocks = -1; return; }
        int dev = 0, cus = 0, per_cu = 0;
        hipGetDevice(&dev);
        hipDeviceGetAttribute(&cus, hipDeviceAttributeMultiprocessorCount, dev);
        if (hipFuncSetAttribute((const void*)fwd_megakernel, hipFuncAttributeMaxDynamicSharedMemorySize, LDS_BYTES) != hipSuccess) fprintf(stderr, "kernel_launch: hipFuncSetAttribute failed\n");
        if (hipOccupancyMaxActiveBlocksPerMultiprocessor(&per_cu, (const void*)fwd_megakernel, 512, LDS_BYTES) != hipSuccess || per_cu < 1) { per_cu = 1; (void)hipGetLastError(); }
        grid_blocks = cus * per_cu;
        if (grid_blocks > 256) grid_blocks = 256;
    }
    if (grid_blocks < 0) return;
    Params p{};
    for (int i = 0; i < 23; ++i) p.in[i] = (const float*)d_in[i];
    p.out = (float*)d_out; p.ws = (unsigned char*)d_ws;
    for (int i = 0; i < 8; ++i) p.inv_freq[i] = (float)pow(500000.0, -(double)(2 * i) / 16.0);
    (void)hipMemsetAsync((unsigned char*)d_ws + WS_BAR, 0, 16384, stream);
    void* args[] = {&p};
    hipError_t e = hipLaunchCooperativeKernel((const void*)fwd_megakernel, dim3(grid_blocks), dim3(512), args, LDS_BYTES, stream);
    if (e != hipSuccess) fprintf(stderr, "cooperative launch failed: %s (grid %d)\n", hipGetErrorString(e), grid_blocks);
}
```

```cpp
#include <hip/hip_runtime.h>
#include <hip/hip_cooperative_groups.h>
#include <cstdio>
namespace cg = cooperative_groups;

#define DEV __device__ __forceinline__
#define LAS __attribute__((address_space(3)))
typedef unsigned short bf16_t;
typedef short bf16x8 __attribute__((ext_vector_type(8)));
typedef float f32x4 __attribute__((ext_vector_type(4)));
typedef float f32x16 __attribute__((ext_vector_type(16)));
typedef unsigned u32x4 __attribute__((ext_vector_type(4)));
typedef unsigned u32x2 __attribute__((ext_vector_type(2)));
typedef float f32x2_t __attribute__((ext_vector_type(2)));
typedef int int2_t __attribute__((ext_vector_type(2)));

constexpr int D = 2048, NB = 4, S = 8192, NIN = 10312, NINP = 10496, DFF = 5632, DFF2 = 11264;
constexpr int C_SCX = 0, C_SCB = 512, C_SCC = 1024, C_SSMU = 1536, C_Q = 2048, C_K = 3072, C_V = 3328, C_QI = 3584, C_KI = 4096, C_WI = 4160,
              C_GA = 4168, C_GB = 6216, C_GC = 8264;
constexpr int WAVE_LDS = 17408;
constexpr int LDS_BYTES = 8 * WAVE_LDS + 16;

constexpr size_t WL_WIN = 0;
constexpr size_t WL_WA = WL_WIN + (size_t)NINP * D * 2;
constexpr size_t WL_WB = WL_WA + (size_t)D * 512 * 2;
constexpr size_t WL_WC = WL_WB + (size_t)D * 512 * 2;
constexpr size_t WL_WGLU = WL_WC + (size_t)D * 1024 * 2;
constexpr size_t WL_WOUT = WL_WGLU + (size_t)512 * 512 * 2;
constexpr size_t WL_WUP = WL_WOUT + (size_t)D * D * 2;
constexpr size_t WL_WDOWN = WL_WUP + (size_t)DFF2 * D * 2;
constexpr size_t WL_SIZE = WL_WDOWN + (size_t)D * DFF * 2;
constexpr size_t WS_W = 0;
constexpr size_t WS_CT = WS_W + 2 * WL_SIZE;
constexpr size_t WS_ST = WS_CT + (size_t)NB * S * 8 * 4;
constexpr size_t WS_H = WS_ST + (size_t)NB * S * 8 * 4;
constexpr size_t WS_P = WS_H + (size_t)S * D * 2;
constexpr size_t WS_YA = WS_P + (size_t)S * NINP * 2;
constexpr size_t WS_YB = WS_YA + (size_t)S * 512 * 2;
constexpr size_t WS_Z = WS_YB + (size_t)S * 512 * 2;
constexpr size_t WS_YC = WS_Z + (size_t)S * 512 * 2;
constexpr size_t WS_MB = WS_YC + (size_t)S * 1024 * 2;
constexpr size_t WS_IDX = WS_MB + (size_t)S * D * 2;
constexpr size_t WS_XEND = WS_IDX + (size_t)S * 256 * 4;
constexpr size_t WS_BIG = WS_XEND + (size_t)32 * 64 * 64 * 2 * 4;
constexpr size_t WS_UP = WS_BIG;
constexpr size_t WS_ACT = WS_UP + (size_t)S * DFF2 * 2;
constexpr size_t WS_SC = WS_BIG;
constexpr size_t WS_MF = WS_BIG;
constexpr size_t WS_BAR = WS_ACT + (size_t)S * DFF * 2;
constexpr size_t WS_H2 = WS_BAR + 16384;
constexpr size_t WS_END = WS_H2 + (size_t)S * D * 2;
static_assert(WS_SC + (size_t)2048 * 4 * 8192 * 4 <= WS_END, "score scratch must fit the aliased region");

struct Params {
    const float* in[23];
    float* out;
    unsigned char* ws;
    float inv_freq[8];
};

DEV unsigned cvt_pk_bf16(float lo, float hi) { unsigned r; asm volatile("v_cvt_pk_bf16_f32 %0, %1, %2" : "=v"(r) : "v"(lo), "v"(hi)); return r; }
DEV float bf_lo(unsigned u) { return __uint_as_float(u << 16); }
DEV float bf_hi(unsigned u) { return __uint_as_float(u & 0xffff0000u); }
DEV void unpack8(const u32x4 v, float (&f)[8]) {
#pragma unroll
    for (int i = 0; i < 4; ++i) { f[2 * i] = bf_lo(v[i]); f[2 * i + 1] = bf_hi(v[i]); }
}
DEV u32x4 pack8(const float (&f)[8]) { u32x4 r; r[0] = cvt_pk_bf16(f[0], f[1]); r[1] = cvt_pk_bf16(f[2], f[3]); r[2] = cvt_pk_bf16(f[4], f[5]); r[3] = cvt_pk_bf16(f[6], f[7]); return r; }
DEV float shx(float v, int mask, int lane) { return __int_as_float(__builtin_amdgcn_ds_bpermute((lane ^ mask) << 2, __float_as_int(v))); }
DEV float wave_sum_f(float v, int lane) {
#pragma unroll
    for (int o = 32; o; o >>= 1) v += shx(v, o, lane);
    return v;
}
DEV int wave_sum_i(int v) {
    v += __builtin_amdgcn_update_dpp(0, v, 0xB1, 0xf, 0xf, false);
    v += __builtin_amdgcn_update_dpp(0, v, 0x4E, 0xf, 0xf, false);
    v += __builtin_amdgcn_update_dpp(0, v, 0x141, 0xf, 0xf, false);
    v += __builtin_amdgcn_update_dpp(0, v, 0x140, 0xf, 0xf, false);
    return __builtin_amdgcn_readlane(v, 0) + __builtin_amdgcn_readlane(v, 16) + __builtin_amdgcn_readlane(v, 32) + __builtin_amdgcn_readlane(v, 48);
}
DEV float sigmoidf_(float x) { return 1.f / (1.f + __expf(-x)); }
DEV float gelu_tanh(float x) { const float u = 0.7978845608028654f * (x + 0.044715f * x * x * x); const float t = 1.f - 2.f / (1.f + __expf(2.f * u)); return 0.5f * x * (1.f + t); }
DEV void sincos_acc(float x, float& s, float& c) {
    const float k = rintf(x * 0.636619772367581343f);
    float y = fmaf(k, -1.57073974609375f, x); y = fmaf(k, -5.657970905303955078125e-05f, y); y = fmaf(k, -9.920936294705029468e-10f, y);
    const int q = ((int)k) & 3; const float y2 = y * y;
    const float sf = y + y * y2 * (-1.6666667163e-01f + y2 * (8.3333337680e-03f + y2 * (-1.9841270114e-04f + y2 * 2.7557314297e-06f)));
    const float cf = 1.f + y2 * (-0.5f + y2 * (4.1666667908e-02f + y2 * (-1.3888889225e-03f + y2 * (2.4801587642e-05f + y2 * (-2.7557314297e-07f)))));
    s = (q == 0) ? sf : (q == 1) ? cf : (q == 2) ? -sf : -cf;
    c = (q == 0) ? cf : (q == 1) ? -sf : (q == 2) ? -cf : sf;
}
DEV int opaque_tid(int wv) { int t; asm volatile("v_mbcnt_lo_u32_b32 %0, -1, 0\n\tv_mbcnt_hi_u32_b32 %0, -1, %0" : "=v"(t)); return (wv << 6) + t; }
DEV void wave_mem_sync() { __builtin_amdgcn_fence(__ATOMIC_SEQ_CST, "workgroup"); __builtin_amdgcn_wave_barrier(); }

namespace pg8 {
constexpr int BM = 256, BK = 64, HALF = 128, HTB = HALF * BK * 2, STAGE_BYTES = 8 * HTB, NXCD = 8, WGM = 8;
DEV int lds_byte(int r, int c) { const int st = (r >> 4) * 2 + (c >> 5), rr = r & 15, cc = c & 31, ob = rr * 64 + cc * 2; return st * 1024 + (ob ^ (((ob >> 9) & 1) << 5)); }
DEV void stage_rc(int b, int& R, int& C) { const int st = b / 1024, sb = b % 1024, swz = sb ^ (((sb >> 9) & 1) << 5); R = (st >> 1) * 16 + swz / 64; C = (st & 1) * 32 + (swz % 64) / 2; }
DEV int perm32(int rho) { const int n = rho >> 4, i = rho & 15; return 8 * (i >> 2) + 4 * n + (i & 3); }
struct Unit { int pm, pn; };
struct Gemm { const bf16_t* A; const bf16_t* Bt; int M, N, K; };
struct StaticOrder {
    int nM, nN, nwg, G, c;
    DEV void init(int M, int N, int G_, int c_) { nM = M / BM; nN = N / BM; nwg = nM * nN; G = G_; c = c_; }
    DEV bool next(int i, Unit& u) const {
        const long L = (long)i * G + c; if (L >= nwg) return false;
        int wgid = (int)L; { const int q = nwg / NXCD, r = nwg % NXCD, xcd = wgid % NXCD, off = wgid / NXCD; wgid = (xcd < r ? xcd * (q + 1) : r * (q + 1) + (xcd - r) * q) + off; }
        const int nig = WGM * nN, gid = wgid / nig, fm = gid * WGM, gsz = (nM - fm) < WGM ? (nM - fm) : WGM;
        u.pm = fm + ((wgid % nig) % gsz); u.pn = (wgid % nig) / gsz; return true;
    }
};
template <class Epi>
DEV void gemm_phase(LAS unsigned char* lds, const Gemm g, const StaticOrder& S, const Epi& E, int wv) {
    const int tid = opaque_tid(wv), wid = __builtin_amdgcn_readfirstlane(tid >> 6), lane = tid & 63, wr = wid >> 2, wc = wid & 3, fr = lane & 15, fq = lane >> 4;
    const int K = g.K, nt = K / BK;
    unsigned voffA[2], voffB[2];
#pragma unroll
    for (int i = 0; i < 2; ++i) { int R, C; stage_rc(tid * 16 + i * 8192, R, C); const int Rb = (R & ~31) + perm32(R & 31);
        voffA[i] = (unsigned)(R * K + C) * 2u; voffB[i] = (unsigned)(Rb * K + C) * 2u; }
    const size_t kstep = (size_t)(BK * 2);
    const size_t hstep = (size_t)HALF * K * 2;
    const size_t tstep = 2 * hstep;
    const unsigned ldsw = (unsigned)wid * 1024u;
    const int aoff = lds_byte(wr * 64 + fr, fq * 8), boff = lds_byte(wc * 32 + fr, fq * 8);
#define PG8_SA(b, h) (((b) * 2 + (h)) * HTB)
#define PG8_SB(b, h) ((4 + (b) * 2 + (h)) * HTB)
#define PG8_STAGE(bufoff, gbase, voff) do { _Pragma("unroll") for (int _i = 0; _i < 2; ++_i) \
        __builtin_amdgcn_global_load_lds((const unsigned*)((const char*)(gbase) + (voff)[_i]), (LAS unsigned*)(lds + (bufoff) + ldsw + _i * 8192), 16, 0, 0); } while (0)
#define PG8_LDA(dst, b, h) do { _Pragma("unroll") for (int m = 0; m < 4; ++m) _Pragma("unroll") for (int k = 0; k < 2; ++k) dst[m][k] = *(const LAS bf16x8*)(lds + PG8_SA(b, h) + aoff + m * 2048 + k * 1024); } while (0)
#define PG8_LDB(dst, b, h) do { _Pragma("unroll") for (int n = 0; n < 2; ++n) _Pragma("unroll") for (int k = 0; k < 2; ++k) dst[n][k] = *(const LAS bf16x8*)(lds + PG8_SB(b, h) + boff + n * 2048 + k * 1024); } while (0)
#define PG8_MMA(ai, bj, At, Bt) do { __builtin_amdgcn_s_setprio(1); _Pragma("unroll") for (int m = 0; m < 4; ++m) _Pragma("unroll") for (int n = 0; n < 2; ++n) _Pragma("unroll") for (int k = 0; k < 2; ++k) \
        acc[ai][bj][m][n] = __builtin_amdgcn_mfma_f32_16x16x32_bf16(Bt[n][k], At[m][k], acc[ai][bj][m][n], 0, 0, 0); __builtin_amdgcn_s_setprio(0); } while (0)
#define PG8_WAIT_V(n) asm volatile("s_waitcnt vmcnt(" #n ")" ::: "memory")
#define PG8_WAIT_L(n) asm volatile("s_waitcnt lgkmcnt(" #n ")" ::: "memory")
#define PG8_BAR __builtin_amdgcn_s_barrier()
#define PG8_SCHED __builtin_amdgcn_sched_barrier(0)
    Unit cur, nxt; int ui = 0;
    if (!S.next(0, cur)) return;
    f32x4 acc[2][2][4][2];
#pragma unroll
    for (int a = 0; a < 2; ++a)
#pragma unroll
        for (int b = 0; b < 2; ++b)
#pragma unroll
            for (int m = 0; m < 4; ++m)
#pragma unroll
                for (int n = 0; n < 2; ++n) acc[a][b][m][n] = (f32x4){0.f, 0.f, 0.f, 0.f};
    bf16x8 At[4][2], B0[2][2], B1[2][2];
    const char* cA = (const char*)g.A + (size_t)cur.pm * tstep; const char* cB = (const char*)g.Bt + (size_t)cur.pn * tstep;
    PG8_STAGE(PG8_SB(0, 0), cB, voffB); PG8_STAGE(PG8_SA(0, 0), cA, voffA); PG8_STAGE(PG8_SB(0, 1), cB + hstep, voffB); PG8_STAGE(PG8_SA(0, 1), cA + hstep, voffA);
    if (wr == 1) PG8_BAR;
    PG8_WAIT_V(4); PG8_BAR;
    PG8_STAGE(PG8_SB(1, 0), cB + kstep, voffB); PG8_STAGE(PG8_SA(1, 0), cA + kstep, voffA); PG8_STAGE(PG8_SB(1, 1), cB + hstep + kstep, voffB);
    PG8_WAIT_V(6); PG8_BAR;
    for (;;) {
        const bool has_next = S.next(ui + 1, nxt);
        const char* nA = has_next ? (const char*)g.A + (size_t)nxt.pm * tstep : cA; const char* nB = has_next ? (const char*)g.Bt + (size_t)nxt.pn * tstep : cB;
        for (int t = 0; t < nt; t += 2) {
            const bool last = (t == nt - 2);
            const char* a1 = cA + (size_t)(t + 1) * kstep;
            const char* a2 = last ? nA : cA + (size_t)(t + 2) * kstep; const char* b2 = last ? nB : cB + (size_t)(t + 2) * kstep;
            const char* a3 = a2 + kstep; const char* b3 = b2 + kstep;
            PG8_LDB(B0, 0, 0); PG8_SCHED; PG8_LDA(At, 0, 0); PG8_STAGE(PG8_SA(1, 1), a1 + hstep, voffA);
            PG8_WAIT_L(8); PG8_BAR; PG8_WAIT_L(0); PG8_MMA(0, 0, At, B0); PG8_BAR; PG8_SCHED;
            PG8_LDB(B1, 0, 1); PG8_STAGE(PG8_SB(0, 0), b2, voffB);
            PG8_BAR; PG8_WAIT_L(0); PG8_MMA(0, 1, At, B1); PG8_BAR;
            PG8_LDA(At, 0, 1); PG8_STAGE(PG8_SA(0, 0), a2, voffA);
            PG8_BAR; PG8_WAIT_L(0); PG8_MMA(1, 0, At, B0); PG8_BAR; PG8_SCHED;
            PG8_STAGE(PG8_SB(0, 1), b2 + hstep, voffB);
            PG8_WAIT_V(6); PG8_BAR; PG8_MMA(1, 1, At, B1); PG8_BAR;
            PG8_LDB(B0, 1, 0); PG8_SCHED; PG8_LDA(At, 1, 0); PG8_STAGE(PG8_SA(0, 1), a2 + hstep, voffA);
            PG8_WAIT_L(8); PG8_BAR; PG8_WAIT_L(0); PG8_MMA(0, 0, At, B0); PG8_BAR; PG8_SCHED;
            PG8_LDB(B1, 1, 1); PG8_STAGE(PG8_SB(1, 0), b3, voffB);
            PG8_BAR; PG8_WAIT_L(0); PG8_MMA(0, 1, At, B1); PG8_BAR;
            PG8_LDA(At, 1, 1); PG8_STAGE(PG8_SA(1, 0), a3, voffA);
            PG8_BAR; PG8_WAIT_L(0); PG8_MMA(1, 0, At, B0); PG8_BAR; PG8_SCHED;
            PG8_STAGE(PG8_SB(1, 1), b3 + hstep, voffB);
            PG8_WAIT_V(6); PG8_BAR; PG8_MMA(1, 1, At, B1); PG8_BAR;
        }
        E(acc, cur, wr, wc, fr, fq);
        if (!has_next) break;
#pragma unroll
        for (int a = 0; a < 2; ++a)
#pragma unroll
            for (int b = 0; b < 2; ++b)
#pragma unroll
                for (int m = 0; m < 4; ++m)
#pragma unroll
                    for (int n = 0; n < 2; ++n) acc[a][b][m][n] = (f32x4){0.f, 0.f, 0.f, 0.f};
        cur = nxt; cA = nA; cB = nB; ++ui;
    }
    PG8_WAIT_V(0);
    if (wr == 0) PG8_BAR;
    PG8_BAR;
#undef PG8_SA
#undef PG8_SB
#undef PG8_STAGE
#undef PG8_LDA
#undef PG8_LDB
#undef PG8_MMA
#undef PG8_WAIT_V
#undef PG8_WAIT_L
#undef PG8_BAR
#undef PG8_SCHED
}
}
using pg8::Unit;

#define EPI_ROWS_BEGIN _Pragma("unroll") for (int ai = 0; ai < 2; ++ai) _Pragma("unroll") for (int m = 0; m < 4; ++m) { const int row = u.pm * 256 + ai * 128 + wr * 64 + m * 16 + fr;
#define EPI_COLS_BEGIN _Pragma("unroll") for (int bj = 0; bj < 2; ++bj) { const int c8 = u.pn * 256 + bj * 128 + wc * 32 + fq * 8; f32x4 v0 = acc[ai][bj][m][0], v1 = acc[ai][bj][m][1];
#define EPI_END } }

struct EpiP {
    bf16_t* P; const float* ct; const float* st;
    int col0;
    DEV void operator()(const f32x4 (&acc)[2][2][4][2], const Unit& u, int wr, int wc, int fr, int fq) const {
        EPI_ROWS_BEGIN EPI_COLS_BEGIN
            const int cb = col0 + u.pn * 256 + bj * 128 + wc * 32;
            const bool rope = ((cb & 63) == 0) && ((cb >= C_Q && cb < C_V) || (cb >= C_QI && cb < C_WI));
            if (rope) {
                f32x4 p0, p1;
#pragma unroll
                for (int i = 0; i < 4; ++i) { p0[i] = shx(v0[i], 16, fq * 16 + fr); p1[i] = shx(v1[i], 16, fq * 16 + fr); }
                if (fq < 2) {
                    const f32x4 c0 = *(const f32x4*)(ct + (size_t)row * 8), c1 = *(const f32x4*)(ct + (size_t)row * 8 + 4);
                    const f32x4 s0 = *(const f32x4*)(st + (size_t)row * 8), s1 = *(const f32x4*)(st + (size_t)row * 8 + 4);
                    const float sg = (fq == 0) ? -1.f : 1.f;
                    v0 = v0 * c0 + sg * (p0 * s0); v1 = v1 * c1 + sg * (p1 * s1);
                }
            }
            u32x4 o; o[0] = cvt_pk_bf16(v0[0], v0[1]); o[1] = cvt_pk_bf16(v0[2], v0[3]); o[2] = cvt_pk_bf16(v1[0], v1[1]); o[3] = cvt_pk_bf16(v1[2], v1[3]);
            *(u32x4*)(P + (size_t)row * NINP + col0 + c8) = o;
        EPI_END
    }
};
struct EpiStore {
    bf16_t* O; int ldc;
    DEV void operator()(const f32x4 (&acc)[2][2][4][2], const Unit& u, int wr, int wc, int fr, int fq) const {
        EPI_ROWS_BEGIN EPI_COLS_BEGIN
            u32x4 o; o[0] = cvt_pk_bf16(v0[0], v0[1]); o[1] = cvt_pk_bf16(v0[2], v0[3]); o[2] = cvt_pk_bf16(v1[0], v1[1]); o[3] = cvt_pk_bf16(v1[2], v1[3]);
            *(u32x4*)(O + (size_t)row * ldc + c8) = o;
        EPI_END
    }
};
struct EpiGlu {
    const bf16_t* Z; bf16_t* YB;
    DEV void operator()(const f32x4 (&acc)[2][2][4][2], const Unit& u, int wr, int wc, int fr, int fq) const {
        EPI_ROWS_BEGIN EPI_COLS_BEGIN
            float z[8]; unpack8(*(const u32x4*)(Z + (size_t)row * 512 + c8), z);
            float o[8];
#pragma unroll
            for (int i = 0; i < 4; ++i) { o[i] = z[i] * sigmoidf_(v0[i]); o[4 + i] = z[4 + i] * sigmoidf_(v1[i]); }
            *(u32x4*)(YB + (size_t)row * 512 + c8) = pack8(o);
        EPI_END
    }
};
template <int MODE> struct EpiMerge {
    const bf16_t* G;
    float* MF; bf16_t* MB;
    DEV void operator()(const f32x4 (&acc)[2][2][4][2], const Unit& u, int wr, int wc, int fr, int fq) const {
        EPI_ROWS_BEGIN EPI_COLS_BEGIN
            float gt[8]; unpack8(*(const u32x4*)(G + (size_t)row * NINP + c8), gt);
            float o[8];
#pragma unroll
            for (int i = 0; i < 4; ++i) { o[i] = sigmoidf_(gt[i]) * v0[i]; o[4 + i] = sigmoidf_(gt[4 + i]) * v1[i]; }
            bf16_t* mp = MB + (size_t)row * D + c8;
            if (MODE != 0) { float a[8]; unpack8(*(const u32x4*)mp, a);
#pragma unroll
                for (int i = 0; i < 8; ++i) o[i] += a[i]; }
            *(u32x4*)mp = pack8(o);
        EPI_END
    }
};
struct EpiResid {
    const float* res; float* out;
    DEV void operator()(const f32x4 (&acc)[2][2][4][2], const Unit& u, int wr, int wc, int fr, int fq) const {
        EPI_ROWS_BEGIN EPI_COLS_BEGIN
            const float* rp = res + (size_t)row * D + c8; float* op = out + (size_t)row * D + c8;
            const f32x4 r0 = *(const f32x4*)rp, r1 = *(const f32x4*)(rp + 4);
            *(f32x4*)op = r0 + v0; *(f32x4*)(op + 4) = r1 + v1;
        EPI_END
    }
};

template <class Epi> DEV void run_gemm_c(unsigned char* shm, int wv, const bf16_t* A, const bf16_t* Bt, int M, int N, int K, const Epi& E, int c) {
    pg8::Gemm g; g.A = A; g.Bt = Bt; g.M = M; g.N = N; g.K = K;
    pg8::StaticOrder So; So.init(M, N, (int)gridDim.x, c);
    pg8::gemm_phase<Epi>((LAS unsigned char*)shm, g, So, E, wv);
}
template <class Epi> DEV void run_gemm(unsigned char* shm, int wv, const bf16_t* A, const bf16_t* Bt, int M, int N, int K, const Epi& E) {
    pg8::Gemm g; g.A = A; g.Bt = Bt; g.M = M; g.N = N; g.K = K;
    pg8::StaticOrder So; So.init(M, N, (int)gridDim.x, (int)blockIdx.x);
    pg8::gemm_phase<Epi>((LAS unsigned char*)shm, g, So, E, wv);
}

DEV void convT(const float* __restrict__ src, int K, int N, bf16_t* __restrict__ dst, int Npad, unsigned char* shm, int wv) {
    float* tile = (float*)shm;
    const int tid = opaque_tid(wv), tk = K / 64, tn = Npad / 64, nt = tk * tn, G = (int)gridDim.x;
    for (int t = blockIdx.x; t < nt; t += 4 * G) {
        __syncthreads();
        float v[4][8];
#pragma unroll
        for (int q = 0; q < 4; ++q) { const int tt = t + q * G;
            if (tt < nt) { const int n0 = (tt % tn) * 64, k0 = (tt / tn) * 64;
#pragma unroll
                for (int i = 0; i < 8; ++i) { const int k = i * 8 + (tid >> 6), n = tid & 63; v[q][i] = (n0 + n < N) ? src[(size_t)(k0 + k) * N + n0 + n] : 0.f; } } }
#pragma unroll
        for (int q = 0; q < 4; ++q) { const int tt = t + q * G;
            if (tt < nt) {
#pragma unroll
                for (int i = 0; i < 8; ++i) { const int k = i * 8 + (tid >> 6), n = tid & 63; tile[q * 4160 + k * 65 + n] = v[q][i]; } } }
        __syncthreads();
        const int n = tid >> 3, ks = (tid & 7) * 8;
#pragma unroll
        for (int q = 0; q < 4; ++q) { const int tt = t + q * G;
            if (tt < nt) { const int n0 = (tt % tn) * 64, k0 = (tt / tn) * 64;
                float f[8];
#pragma unroll
                for (int j = 0; j < 8; ++j) f[j] = tile[q * 4160 + (ks + j) * 65 + n];
                *(u32x4*)(dst + (size_t)(n0 + n) * K + k0 + ks) = pack8(f); } }
    }
    __syncthreads();
}

DEV void rmsnorm_bf16(const float* x, const float* g, bf16_t* out, int rows, int wv, int blk0, int nblk) {
    const int tid_ = opaque_tid(wv), lane = tid_ & 63, wid = tid_ >> 6, st = nblk * 8;
    for (int r = ((int)blockIdx.x - blk0) * 8 + wid; r < rows; r += 2 * st) {
        const int r1 = r + st; const bool has1 = r1 < rows;
        const f32x4* xa = (const f32x4*)(x + (size_t)r * D); const f32x4* xb = (const f32x4*)(x + (size_t)(has1 ? r1 : r) * D);
        f32x4 va[8], vb[8]; float sa = 0.f, sb = 0.f;
#pragma unroll
        for (int j = 0; j < 8; ++j) { va[j] = xa[j * 64 + lane]; vb[j] = xb[j * 64 + lane]; }
#pragma unroll
        for (int j = 0; j < 8; ++j) { sa += va[j][0] * va[j][0] + va[j][1] * va[j][1] + va[j][2] * va[j][2] + va[j][3] * va[j][3];
            sb += vb[j][0] * vb[j][0] + vb[j][1] * vb[j][1] + vb[j][2] * vb[j][2] + vb[j][3] * vb[j][3]; }
        sa = wave_sum_f(sa, lane); sb = wave_sum_f(sb, lane);
        const float ra = rsqrtf(sa * (1.f / D) + 1e-6f), rb = rsqrtf(sb * (1.f / D) + 1e-6f);
#pragma unroll
        for (int j = 0; j < 8; ++j) { const f32x4 gg = ((const f32x4*)g)[j * 64 + lane];
            u32x2 o; o[0] = cvt_pk_bf16(va[j][0] * ra * gg[0], va[j][1] * ra * gg[1]); o[1] = cvt_pk_bf16(va[j][2] * ra * gg[2], va[j][3] * ra * gg[3]);
            *(u32x2*)(out + (size_t)r * D + (j * 64 + lane) * 4) = o;
            if (has1) { u32x2 q; q[0] = cvt_pk_bf16(vb[j][0] * rb * gg[0], vb[j][1] * rb * gg[1]); q[1] = cvt_pk_bf16(vb[j][2] * rb * gg[2], vb[j][3] * rb * gg[3]);
                *(u32x2*)(out + (size_t)r1 * D + (j * 64 + lane) * 4) = q; } }
    }
}
DEV void rmsnorm_f32_inplace(float* x, const float* g, int rows, int wv) {
    const int tid_ = opaque_tid(wv), lane = tid_ & 63, wid = tid_ >> 6, st = (int)gridDim.x * 8;
    for (int r = blockIdx.x * 8 + wid; r < rows; r += 2 * st) {
        const int r1 = r + st; const bool has1 = r1 < rows;
        f32x4* xa = (f32x4*)(x + (size_t)r * D); f32x4* xb = (f32x4*)(x + (size_t)(has1 ? r1 : r) * D);
        f32x4 va[8], vb[8]; float sa = 0.f, sb = 0.f;
#pragma unroll
        for (int j = 0; j < 8; ++j) { va[j] = xa[j * 64 + lane]; vb[j] = xb[j * 64 + lane]; }
#pragma unroll
        for (int j = 0; j < 8; ++j) { sa += va[j][0] * va[j][0] + va[j][1] * va[j][1] + va[j][2] * va[j][2] + va[j][3] * va[j][3];
            sb += vb[j][0] * vb[j][0] + vb[j][1] * vb[j][1] + vb[j][2] * vb[j][2] + vb[j][3] * vb[j][3]; }
        sa = wave_sum_f(sa, lane); sb = wave_sum_f(sb, lane);
        const float ra = rsqrtf(sa * (1.f / D) + 1e-6f), rb = rsqrtf(sb * (1.f / D) + 1e-6f);
#pragma unroll
        for (int j = 0; j < 8; ++j) { const f32x4 gg = ((const f32x4*)g)[j * 64 + lane]; xa[j * 64 + lane] = va[j] * ra * gg; if (has1) xb[j * 64 + lane] = vb[j] * rb * gg; }
    }
}

DEV void ssm_coef(const Params& p, int l, int g, int n, float& abr, float& abi, float (&Br)[16], float (&Bi)[16]) {
    const int gi = l * 32 + g;
    const float are = p.in[5][gi * 64 + n], aim = p.in[6][gi * 64 + n], dt = expf(p.in[7][gi]);
    const float mag = expf(dt * are); float sn, cs; sincos_acc(dt * aim, sn, cs);
    abr = mag * cs; abi = mag * sn;
    const float nr = abr - 1.f, ni = abi, den = are * are + aim * aim;
    const float qr = (nr * are + ni * aim) / den, qi = (ni * are - nr * aim) / den;
    const float* bre = p.in[8] + (size_t)(gi * 64 + n) * 16; const float* bim = p.in[9] + (size_t)(gi * 64 + n) * 16;
#pragma unroll
    for (int q = 0; q < 16; ++q) { const float br = bre[q], bi = bim[q]; Br[q] = qr * br - qi * bi; Bi[q] = qr * bi + qi * br; }
}
DEV void load_u16(const bf16_t* ptr, float (&u)[16]) {
    const u32x4 a = *(const u32x4*)ptr, b = *(const u32x4*)(ptr + 8);
#pragma unroll
    for (int i = 0; i < 4; ++i) { u[2 * i] = bf_lo(a[i]); u[2 * i + 1] = bf_hi(a[i]); u[8 + 2 * i] = bf_lo(b[i]); u[8 + 2 * i + 1] = bf_hi(b[i]); }
}
DEV void ssm_stage_u(const bf16_t* P, int g, int c, int lane, bf16_t* us) {
    wave_mem_sync();
#pragma unroll
    for (int j = 0; j < 2; ++j) { const int tt = 2 * lane + j; const bf16_t* src = P + (size_t)(c * 128 + tt) * NINP + C_SSMU + g * 16;
        const u32x4 a = *(const u32x4*)src, b = *(const u32x4*)(src + 8); *(u32x4*)(us + tt * 16) = a; *(u32x4*)(us + tt * 16 + 8) = b; }
    wave_mem_sync();
}
DEV void ssm_pass1(const Params& p, int l, const bf16_t* P, float* XEND, int g, int c, int lane, bf16_t* us) {
    ssm_stage_u(P, g, c, lane, us);
    float abr, abi, Br[16], Bi[16]; ssm_coef(p, l, g, lane, abr, abi, Br, Bi);
    float xr = 0.f, xi = 0.f;
#pragma unroll 4
    for (int tt = 0; tt < 128; ++tt) {
        float u[16]; load_u16(us + tt * 16, u);
        float br = 0.f, bi = 0.f;
#pragma unroll
        for (int q = 0; q < 16; ++q) { br += Br[q] * u[q]; bi += Bi[q] * u[q]; }
        const float nr = abr * xr - abi * xi + br, ni = abr * xi + abi * xr + bi; xr = nr; xi = ni;
    }
    float* xe = XEND + ((size_t)(g * 64 + c) * 64 + lane) * 2; xe[0] = xr; xe[1] = xi;
}
DEV void ssm_pass2(const Params& p, int l, const bf16_t* P, const float* XEND, bf16_t* Z, int g, int c, int lane, bf16_t* us) {
    ssm_stage_u(P, g, c, lane, us);
    unsigned* xs = (unsigned*)(us + 128 * 16);
    float abr, abi, Br[16], Bi[16]; ssm_coef(p, l, g, lane, abr, abi, Br, Bi);
    const int gi = l * 32 + g, fr = lane & 15, fq = lane >> 4;
    bf16x8 Ca[4];
#pragma unroll
    for (int s4 = 0; s4 < 4; ++s4) {
        const int n0 = 16 * s4 + 4 * fq;
        const f32x4 cr = *(const f32x4*)(p.in[10] + (size_t)(gi * 16 + fr) * 64 + n0), ci = *(const f32x4*)(p.in[11] + (size_t)(gi * 16 + fr) * 64 + n0);
        u32x4 pk;
#pragma unroll
        for (int i = 0; i < 4; ++i) pk[i] = cvt_pk_bf16(cr[i], -ci[i]);
        Ca[s4] = __builtin_bit_cast(bf16x8, pk);
    }
    const f32x4 dsk = *(const f32x4*)(p.in[12] + l * 512 + g * 16 + 4 * fq);
    float pr = abr, pi = abi;
#pragma unroll
    for (int i = 0; i < 7; ++i) { const float nr = pr * pr - pi * pi, ni = 2.f * pr * pi; pr = nr; pi = ni; }
    float xr = 0.f, xi = 0.f;
    for (int cc = 0; cc < c; ++cc) { const float* xe = XEND + ((size_t)(g * 64 + cc) * 64 + lane) * 2; const float er = xe[0], ei = xe[1];
        const float nr = pr * xr - pi * xi + er, ni = pr * xi + pi * xr + ei; xr = nr; xi = ni; }
    for (int tb = 0; tb < 8; ++tb) {
#pragma unroll 4
        for (int t16 = 0; t16 < 16; ++t16) {
            const int tt = tb * 16 + t16;
            float u[16]; load_u16(us + tt * 16, u);
            float br0 = 0.f, bi0 = 0.f, br1 = 0.f, bi1 = 0.f;
#pragma unroll
            for (int q = 0; q < 8; ++q) { br0 += Br[q] * u[q]; bi0 += Bi[q] * u[q]; br1 += Br[8 + q] * u[8 + q]; bi1 += Bi[8 + q] * u[8 + q]; }
            const float nr = abr * xr - abi * xi + (br0 + br1), ni = abr * xi + abi * xr + (bi0 + bi1); xr = nr; xi = ni;
            xs[t16 * 64 + lane] = cvt_pk_bf16(xr, xi);
        }
        wave_mem_sync();
        f32x4 acc = (f32x4){0.f, 0.f, 0.f, 0.f};
#pragma unroll
        for (int s4 = 0; s4 < 4; ++s4) { const bf16x8 xb = *(const bf16x8*)(xs + fr * 64 + 16 * s4 + 4 * fq); acc = __builtin_amdgcn_mfma_f32_16x16x32_bf16(Ca[s4], xb, acc, 0, 0, 0); }
        const u32x2 uu = *(const u32x2*)(us + (tb * 16 + fr) * 16 + 4 * fq);
        const float y0 = acc[0] + dsk[0] * bf_lo(uu[0]), y1 = acc[1] + dsk[1] * bf_hi(uu[0]), y2 = acc[2] + dsk[2] * bf_lo(uu[1]), y3 = acc[3] + dsk[3] * bf_hi(uu[1]);
        u32x2 zz; zz[0] = cvt_pk_bf16(gelu_tanh(y0), gelu_tanh(y1)); zz[1] = cvt_pk_bf16(gelu_tanh(y2), gelu_tanh(y3));
        *(u32x2*)(Z + (size_t)(c * 128 + tb * 16 + fr) * 512 + g * 16 + 4 * fq) = zz;
        wave_mem_sync();
    }
}

template <int NR>
DEV int count_ge_all(const unsigned (&key)[NR], unsigned cand) {
    int c0 = 0, c1 = 0, c2 = 0, c3 = 0;
#pragma unroll
    for (int j = 0; j < NR; j += 4) {
        unsigned long long m0, m1, m2, m3;
        asm volatile("s_nop 1\n\t"
                     "v_cmp_le_u32_e64 %[m0], %[cand], %[k0]\n\t"
                     "v_cmp_le_u32_e64 %[m1], %[cand], %[k1]\n\t"
                     "v_cmp_le_u32_e64 %[m2], %[cand], %[k2]\n\t"
                     "v_cmp_le_u32_e64 %[m3], %[cand], %[k3]\n\t"
                     "v_addc_co_u32_e64 %[c0], %[m0], 0, %[c0], %[m0]\n\t"
                     "v_addc_co_u32_e64 %[c1], %[m1], 0, %[c1], %[m1]\n\t"
                     "v_addc_co_u32_e64 %[c2], %[m2], 0, %[c2], %[m2]\n\t"
                     "v_addc_co_u32_e64 %[c3], %[m3], 0, %[c3], %[m3]"
                     : [c0] "+v"(c0), [c1] "+v"(c1), [c2] "+v"(c2), [c3] "+v"(c3), [m0] "=&s"(m0), [m1] "=&s"(m1), [m2] "=&s"(m2), [m3] "=&s"(m3)
                     : [cand] "s"(cand), [k0] "v"(key[j]), [k1] "v"(key[j + 1]), [k2] "v"(key[j + 2]), [k3] "v"(key[j + 3]));
    }
    return (c0 + c1) + (c2 + c3);
}
template <int NR>
DEV void select_topk(const float* __restrict__ sc, int t, int lane, int* __restrict__ idx_out) {
    asm volatile("" : "+v"(lane));
    unsigned key[NR];
    const int nr = (t >> 6) + 1;
#pragma unroll
    for (int j = 0; j < NR; ++j) { unsigned u = 0u;
        if (j < nr) { u = __float_as_uint(sc[j * 64 + lane]); u = (u & 0x80000000u) ? ~u : (u | 0x80000000u); }
        key[j] = u; }
    unsigned thr = 0u;
    for (int bit = 31; bit >= 0; --bit) {
        const unsigned cand = __builtin_amdgcn_readfirstlane(thr | (1u << bit));
        int c = count_ge_all<NR>(key, cand);
        c = __builtin_amdgcn_readfirstlane(wave_sum_i(c));
        if (c >= 256) { thr = cand; if (c == 256) break; }
    }
    int cgt = 0;
    { const unsigned thr1 = __builtin_amdgcn_readfirstlane(thr + 1u);
      cgt = count_ge_all<NR>(key, thr1); }
    cgt = __builtin_amdgcn_readfirstlane(wave_sum_i(cgt));
    int need = 256 - cgt, base = 0;
#pragma unroll
    for (int j = 0; j < NR; ++j) {
        const bool gt = key[j] > thr, eq = key[j] == thr;
        const unsigned long long meq = __ballot(eq);
        const int peq = (int)__builtin_amdgcn_mbcnt_hi((unsigned)(meq >> 32), __builtin_amdgcn_mbcnt_lo((unsigned)meq, 0u));
        const bool take = gt || (eq && peq < need);
        const int neq = __popcll(meq); need = (need > neq) ? need - neq : 0;
        const unsigned long long mt = __ballot(take);
        const int pos = base + (int)__builtin_amdgcn_mbcnt_hi((unsigned)(mt >> 32), __builtin_amdgcn_mbcnt_lo((unsigned)mt, 0u));
        if (take && pos < 256) idx_out[pos] = j * 64 + lane;
        base += __popcll(mt);
        __builtin_amdgcn_sched_barrier(0);
    }
}
DEV void indexer_task(const bf16_t* P, int t0, float* sc, int* IDX, int lane, void* kbuf  ) {
    int ln = lane; asm volatile("" : "+v"(ln));
    const int hh = ln >> 5, r = ln & 31;
    const int jj = r >> 3, hb = (r >> 2) & 1, ii = r & 3;
    const int qa = 2 * hb + (jj >> 1), ha = 4 * (jj & 1) + ii;
    bf16x8 afr[4];
    { const bf16_t* ap = P + (size_t)(t0 + qa) * NINP + C_QI + ha * 64 + 8 * hh;
#pragma unroll
      for (int kk = 0; kk < 4; ++kk) afr[kk] = *(const bf16x8*)(ap + 16 * kk); }
    float w0[8], w1[8];
    unpack8(*(const u32x4*)(P + (size_t)(t0 + 2 * hh) * NINP + C_WI), w0);
    unpack8(*(const u32x4*)(P + (size_t)(t0 + 2 * hh + 1) * NINP + C_WI), w1);
    const int ngrp = ((t0 + 3) >> 6) + 1;
    const int tq0 = t0 + 2 * hh, tq1 = tq0 + 1;
    const float ninf = -__builtin_huge_valf();
    unsigned char* kb = (unsigned char*)kbuf;
    const int lrow = ln >> 3, lch = ln & 7;
#define IDX_FETCH(regs, g) do { _Pragma("unroll") for (int i = 0; i < 8; ++i) regs[i] = *(const u32x4*)(P + (size_t)((g) * 64 + i * 8 + lrow) * NINP + C_KI + lch * 8); } while (0)
#define IDX_PARK(regs, bsel) do { _Pragma("unroll") for (int i = 0; i < 8; ++i) { const int kl = i * 8 + lrow; \
        *(u32x4*)(kb + (bsel) * 8192 + kl * 128 + ((lch ^ (kl & 7)) << 4)) = regs[i]; } } while (0)
#define IDX_SCORE(bsel, g) do { _Pragma("unroll") for (int u = 0; u < 2; ++u) { const int s = (g) * 64 + u * 32 + r; const int kl = u * 32 + r; f32x16 acc; \
        _Pragma("unroll") for (int i = 0; i < 16; ++i) acc[i] = 0.f; \
        _Pragma("unroll") for (int kk = 0; kk < 4; ++kk) { const bf16x8 bv = *(const bf16x8*)(kb + (bsel) * 8192 + kl * 128 + (((2 * kk + hh) ^ (kl & 7)) << 4)); \
            acc = __builtin_amdgcn_mfma_f32_32x32x16_bf16(afr[kk], bv, acc, 0, 0, 0); } \
        float s0 = 0.f, s1 = 0.f; \
        _Pragma("unroll") for (int j = 0; j < 8; ++j) { s0 += w0[j] * fmaxf(acc[j], 0.f); s1 += w1[j] * fmaxf(acc[8 + j], 0.f); } \
        sc[(size_t)(2 * hh) * 8192 + s] = (s <= tq0) ? s0 : ninf; sc[(size_t)(2 * hh + 1) * 8192 + s] = (s <= tq1) ? s1 : ninf; } } while (0)
    u32x4 kreg[8];
    wave_mem_sync();
    IDX_FETCH(kreg, 0); IDX_PARK(kreg, 0);
    wave_mem_sync();
    for (int grp = 0; grp < ngrp; ++grp) {
        const int g1 = (grp + 1 < ngrp) ? grp + 1 : grp;
        IDX_FETCH(kreg, g1);
        IDX_SCORE(grp & 1, grp);
        IDX_PARK(kreg, (grp + 1) & 1);
        wave_mem_sync();
    }
#undef IDX_FETCH
#undef IDX_PARK
#undef IDX_SCORE
    asm volatile("s_waitcnt vmcnt(0)" ::: "memory");
    wave_mem_sync();
    for (int qq = 0; qq < 4; ++qq) {
        const int t = t0 + qq;
        if (t < 256) continue;
        const int nr = (t >> 6) + 1;
        const float* scq = sc + (size_t)qq * 8192; int* io = IDX + (size_t)t * 256;
        if (nr <= 32) select_topk<32>(scq, t, lane, io);
        else if (nr <= 64) select_topk<64>(scq, t, lane, io);
        else if (nr <= 96) select_topk<96>(scq, t, lane, io);
        else select_topk<128>(scq, t, lane, io);
    }
}

typedef __bf16 bf16x2_t __attribute__((ext_vector_type(2)));
DEV float dot2bf(unsigned a, unsigned b, float c) { return __builtin_amdgcn_fdot2_f32_bf16(__builtin_bit_cast(bf16x2_t, a), __builtin_bit_cast(bf16x2_t, b), c, false); }
DEV void attn_query(const bf16_t* P, const int* IDX, bf16_t* YC, int t, int lane, float* lg, int* ids) {
    const int nk = (t < 255) ? t + 1 : 256;
    wave_mem_sync();
#pragma unroll
    for (int j = 0; j < 4; ++j) { const int k = lane + 64 * j; ids[k] = (t < 256) ? ((k <= t) ? k : 0) : IDX[(size_t)t * 256 + k]; }
    wave_mem_sync();
    const int fr = lane & 15, fq = lane >> 4;
    {
        bf16x8 bq[4][2];
#pragma unroll
        for (int g = 0; g < 4; ++g)
#pragma unroll
            for (int kk = 0; kk < 2; ++kk) {
                if (fr < 4) bq[g][kk] = *(const bf16x8*)(P + (size_t)t * NINP + C_Q + (4 * g + fr) * 64 + 32 * kk + 8 * fq);
                else bq[g][kk] = (bf16x8){0, 0, 0, 0, 0, 0, 0, 0};
            }
        const int ntile = (nk + 15) >> 4;
        bf16x8 acur[4][2];
        { const bf16_t* kp = P + (size_t)ids[fr] * NINP + C_K + 8 * fq;
#pragma unroll
          for (int g = 0; g < 4; ++g)
#pragma unroll
              for (int kk = 0; kk < 2; ++kk) acur[g][kk] = *(const bf16x8*)(kp + 64 * g + 32 * kk); }
        for (int tl = 0; tl < ntile; ++tl) {
            const int tn = (tl + 1 < ntile) ? tl + 1 : tl;
            const bf16_t* kp = P + (size_t)ids[tn * 16 + fr] * NINP + C_K + 8 * fq;
            bf16x8 anxt[4][2];
#pragma unroll
            for (int g = 0; g < 4; ++g)
#pragma unroll
                for (int kk = 0; kk < 2; ++kk) anxt[g][kk] = *(const bf16x8*)(kp + 64 * g + 32 * kk);
#pragma unroll
            for (int g = 0; g < 4; ++g) {
                f32x4 acc = (f32x4){0.f, 0.f, 0.f, 0.f};
                acc = __builtin_amdgcn_mfma_f32_16x16x32_bf16(acur[g][0], bq[g][0], acc, 0, 0, 0);
                acc = __builtin_amdgcn_mfma_f32_16x16x32_bf16(acur[g][1], bq[g][1], acc, 0, 0, 0);
                if (fr < 4) {
                    const int kp0 = tl * 8 + 2 * fq, hd = 4 * g + fr;
                    *(f32x2_t*)(lg + (kp0 * 16 + hd) * 2) = (f32x2_t){acc[0] * 0.125f, acc[1] * 0.125f};
                    *(f32x2_t*)(lg + ((kp0 + 1) * 16 + hd) * 2) = (f32x2_t){acc[2] * 0.125f, acc[3] * 0.125f};
                }
            }
#pragma unroll
            for (int g = 0; g < 4; ++g)
#pragma unroll
                for (int kk = 0; kk < 2; ++kk) acur[g][kk] = anxt[g][kk];
        }
    }
    wave_mem_sync();
    {
        const int h = lane & 15, kq = lane >> 4;
        float v[64]; float mx = -3.0e38f;
#pragma unroll
        for (int j = 0; j < 32; ++j) { const int kp = 4 * j + kq; const f32x2_t x = *(const f32x2_t*)(lg + (kp * 16 + h) * 2);
            v[2 * j] = (2 * kp < nk) ? x[0] : -3.0e38f; v[2 * j + 1] = (2 * kp + 1 < nk) ? x[1] : -3.0e38f; mx = fmaxf(mx, fmaxf(v[2 * j], v[2 * j + 1])); }
        mx = fmaxf(mx, shx(mx, 16, lane)); mx = fmaxf(mx, shx(mx, 32, lane));
        float sm = 0.f;
#pragma unroll
        for (int j = 0; j < 32; ++j) { const int kp = 4 * j + kq;
            v[2 * j] = (2 * kp < nk) ? __expf(v[2 * j] - mx) : 0.f; v[2 * j + 1] = (2 * kp + 1 < nk) ? __expf(v[2 * j + 1] - mx) : 0.f; sm += v[2 * j] + v[2 * j + 1]; }
        sm += shx(sm, 16, lane); sm += shx(sm, 32, lane);
        const float inv = 1.f / sm;
        wave_mem_sync();
        unsigned* pP = (unsigned*)lg;
#pragma unroll
        for (int j = 0; j < 32; ++j) { const int kp = 4 * j + kq; pP[kp * 16 + h] = cvt_pk_bf16(v[2 * j] * inv, v[2 * j + 1] * inv); }
    }
    wave_mem_sync();
    {
        const unsigned* pP = (const unsigned*)lg;
        const int ks = lane >> 5, dq = lane & 31, g = dq >> 3;
        float o[4][8];
#pragma unroll
        for (int r = 0; r < 4; ++r)
#pragma unroll
            for (int i = 0; i < 8; ++i) o[r][i] = 0.f;
        const int nit = (((nk + 1) >> 1) + 1) >> 1, ngrp = (nit + 3) >> 2;
#define PV_LOAD(A, B, grp) do { _Pragma("unroll") for (int u = 0; u < 4; ++u) { const int kp = 2 * ((grp) * 4 + u) + ks; const int2_t rr = *(const int2_t*)(ids + 2 * kp); \
            A[u] = *(const u32x4*)(P + (size_t)rr[0] * NINP + C_V + 8 * dq); B[u] = *(const u32x4*)(P + (size_t)rr[1] * NINP + C_V + 8 * dq); } } while (0)
#define PV_ACC(A, B, grp) do { _Pragma("unroll") for (int u = 0; u < 4; ++u) { const int kp = 2 * ((grp) * 4 + u) + ks; const u32x4 pp = *(const u32x4*)(pP + kp * 16 + 4 * g); \
            _Pragma("unroll") for (int i = 0; i < 4; ++i) { const unsigned ev = __builtin_amdgcn_perm(B[u][i], A[u][i], 0x05040100u), od = __builtin_amdgcn_perm(B[u][i], A[u][i], 0x07060302u); \
                _Pragma("unroll") for (int r = 0; r < 4; ++r) { o[r][2 * i] = dot2bf(ev, pp[r], o[r][2 * i]); o[r][2 * i + 1] = dot2bf(od, pp[r], o[r][2 * i + 1]); } } } } while (0)
        u32x4 ra[4], rb[4], na[4], nb[4];
        PV_LOAD(ra, rb, 0);
        for (int grp = 0; grp < ngrp; grp += 2) {
            { const int g1 = (grp + 1 < ngrp) ? grp + 1 : grp; PV_LOAD(na, nb, g1); }
            PV_ACC(ra, rb, grp);
            if (grp + 1 < ngrp) {
                { const int g2 = (grp + 2 < ngrp) ? grp + 2 : grp + 1; PV_LOAD(ra, rb, g2); }
                PV_ACC(na, nb, grp + 1);
            }
        }
#undef PV_LOAD
#undef PV_ACC
#pragma unroll
        for (int r = 0; r < 4; ++r)
#pragma unroll
            for (int i = 0; i < 8; ++i) o[r][i] += shx(o[r][i], 32, lane);
        if (ks == 0) {
#pragma unroll
            for (int r = 0; r < 4; ++r) *(u32x4*)(YC + (size_t)t * 1024 + (4 * g + r) * 64 + 8 * (dq & 7)) = pack8(o[r]);
        }
    }
}

#define XB_TMO      128
#define XB_XCNT(j)  (256  + 64 * (j))
#define XB_XSUB(j)  (1280 + 64 * (j))
#define XB_XGEN(j)  (2304 + 64 * (j))
#define XB_TOP      3328
#define XB_TOPGEN   3392
#define XCD_BAR_WORDS 3456
#define XB_SPIN_CAP (1u << 22)
DEV unsigned xb_ld(unsigned* p)              { return __hip_atomic_load(p, __ATOMIC_RELAXED, __HIP_MEMORY_SCOPE_AGENT); }
DEV unsigned xb_add(unsigned* p, unsigned v) { return __hip_atomic_fetch_add(p, v, __ATOMIC_RELAXED, __HIP_MEMORY_SCOPE_AGENT); }
DEV unsigned xb_xcc_id() { return (unsigned)__builtin_amdgcn_s_getreg((3 << 11) | 20) & 0xFu; }
#define XB_SPIN(cond, bar) do { unsigned _sp = 0; while (cond) { __builtin_amdgcn_s_sleep(1); \
    if ((++_sp & 255u) == 0u) { if (xb_ld(&(bar)[XB_TMO])) break; if (_sp > XB_SPIN_CAP) { atomicAdd(&(bar)[XB_TMO], 1u); break; } } } } while (0)
struct XcdBarrier { unsigned* bar; unsigned x; volatile LAS unsigned* st; };
DEV void xcd_barrier_complete(unsigned* bar, unsigned x, unsigned& nloc, unsigned& nx) {
    const unsigned G = gridDim.x;
    unsigned sum, cnt, mine, sp = 0u;
    for (;;) {
        sum = 0u; cnt = 0u; mine = 0u;
#pragma unroll
        for (unsigned j = 0; j < 16; ++j) { const unsigned c = xb_ld(&bar[XB_XCNT(j)]); sum += c; cnt += (c > 0u) ? 1u : 0u; mine = (j == x) ? c : mine; }
        if (sum == G) break;
        __builtin_amdgcn_s_sleep(1);
        if ((++sp & 255u) == 0u) { if (xb_ld(&bar[XB_TMO])) break; if (sp > XB_SPIN_CAP) { atomicAdd(&bar[XB_TMO], 1u); break; } }
    }
    nloc = mine > 0u ? mine : 1u; nx = cnt > 0u ? cnt : 1u;
}
DEV void xcd_barrier(const XcdBarrier& b, int wv) {
    asm volatile("s_waitcnt vmcnt(0)" ::: "memory");
    __syncthreads();
    if (opaque_tid(wv) == 0) {
        unsigned* bar = b.bar;
        __builtin_amdgcn_s_waitcnt(0);
        unsigned nloc = b.st[0], nx = b.st[1];
        if (nloc == 0u) { xcd_barrier_complete(bar, b.x, nloc, nx); b.st[0] = nloc; b.st[1] = nx; }
        const unsigned old = xb_add(&bar[XB_XSUB(b.x)], 1u);
        const unsigned gen = old / nloc;
        if (old + 1u == (gen + 1u) * nloc) {
            __builtin_amdgcn_fence(__ATOMIC_RELEASE, "agent");
            asm volatile("s_waitcnt vmcnt(0)" ::: "memory");
            const unsigned og = xb_add(&bar[XB_TOP], 1u);
            const unsigned tg = og / nx;
            if (og + 1u == (tg + 1u) * nx) xb_add(&bar[XB_TOPGEN], 1u);
            else XB_SPIN(xb_ld(&bar[XB_TOPGEN]) == tg, bar);
            __builtin_amdgcn_fence(__ATOMIC_ACQUIRE, "agent");
            xb_add(&bar[XB_XGEN(b.x)], 1u);
            asm volatile("s_waitcnt vmcnt(0)" ::: "memory");
        } else {
            XB_SPIN(xb_ld(&bar[XB_XGEN(b.x)]) == gen, bar);
            __builtin_amdgcn_fence(__ATOMIC_ACQUIRE, "agent");
            asm volatile("s_waitcnt vmcnt(0)" ::: "memory");
        }
    }
    __syncthreads();
}

#ifndef PROBE_PHASE
#define PROBE_PHASE -1
#endif
#define TSTART(k) if (PROBE_PHASE == (k)) t0 = (unsigned)__builtin_amdgcn_s_memrealtime();
#define TEND(k) if (PROBE_PHASE == (k)) tacc += (unsigned)__builtin_amdgcn_s_memrealtime() - t0;
__global__ __launch_bounds__(512, 2) void fwd_megakernel(Params p) {
    extern __shared__ __attribute__((aligned(16))) unsigned char shm[];
    cg::grid_group grid = cg::this_grid();
    const int wv = __builtin_amdgcn_readfirstlane((int)threadIdx.x >> 6);
#define PHASE_IDS const int tid = opaque_tid(wv), lane = tid & 63, wid = __builtin_amdgcn_readfirstlane(tid >> 6); const int gw = blockIdx.x * 8 + wid, nw = gridDim.x * 8; const int gt = blockIdx.x * 512 + tid, nthr = gridDim.x * 512; (void)lane; (void)gw; (void)nw; (void)gt; (void)nthr;
    unsigned char* ws = p.ws;
    unsigned t0 = 0, tacc = 0; (void)t0; (void)tacc;
    XcdBarrier xb; xb.bar = (unsigned*)(ws + WS_BAR); xb.x = xb_xcc_id(); xb.st = (volatile LAS unsigned*)(LAS unsigned char*)(shm + 8 * WAVE_LDS);
    if (opaque_tid(wv) == 0) { xb.st[0] = 0u; xb.st[1] = 0u; (void)xb_add(&xb.bar[XB_XCNT(xb.x)], 1u); }
    __syncthreads();
    TSTART(0)
    float* CT = (float*)(ws + WS_CT); float* ST = (float*)(ws + WS_ST);
    bf16_t* H0 = (bf16_t*)(ws + WS_H); bf16_t* H1 = (bf16_t*)(ws + WS_H2); bf16_t* P = (bf16_t*)(ws + WS_P);
    bf16_t* YA = (bf16_t*)(ws + WS_YA); bf16_t* YB = (bf16_t*)(ws + WS_YB); bf16_t* Z = (bf16_t*)(ws + WS_Z); bf16_t* YC = (bf16_t*)(ws + WS_YC);
    bf16_t* MB = (bf16_t*)(ws + WS_MB); int* IDX = (int*)(ws + WS_IDX); float* XEND = (float*)(ws + WS_XEND);
    bf16_t* UP = (bf16_t*)(ws + WS_UP); bf16_t* ACT = (bf16_t*)(ws + WS_ACT); float* SC = (float*)(ws + WS_SC); float* MF = (float*)(ws + WS_MF);

    for (int l = 0; l < 2; ++l) {
        unsigned char* wl = ws + WS_W + (size_t)l * WL_SIZE;
        convT(p.in[3] + (size_t)l * D * NIN, D, NIN, (bf16_t*)(wl + WL_WIN), NINP, shm, wv);
        convT(p.in[14] + (size_t)l * 512 * D, 512, D, (bf16_t*)(wl + WL_WA), D, shm, wv);
        convT(p.in[15] + (size_t)l * 512 * D, 512, D, (bf16_t*)(wl + WL_WB), D, shm, wv);
        convT(p.in[16] + (size_t)l * 1024 * D, 1024, D, (bf16_t*)(wl + WL_WC), D, shm, wv);
        convT(p.in[13] + (size_t)l * 512 * 512, 512, 512, (bf16_t*)(wl + WL_WGLU), 512, shm, wv);
        convT(p.in[17] + (size_t)l * D * D, D, D, (bf16_t*)(wl + WL_WOUT), D, shm, wv);
        convT(p.in[19] + (size_t)l * D * DFF2, D, DFF2, (bf16_t*)(wl + WL_WUP), DFF2, shm, wv);
        convT(p.in[21] + (size_t)l * DFF * D, DFF, D, (bf16_t*)(wl + WL_WDOWN), D, shm, wv);
    }
    {
        PHASE_IDS
        const int* pos = (const int*)p.in[1];
        for (int i = gt; i < NB * S * 8; i += nthr) { const float ang = (float)pos[i >> 3] * p.inv_freq[i & 7]; float sn, cs; sincos_acc(ang, sn, cs); CT[i] = cs; ST[i] = sn; }
    }
    grid.sync();
    TEND(0)

    for (int l = 0; l < 2; ++l) {
        const unsigned char* wl = ws + WS_W + (size_t)l * WL_SIZE;
        const bf16_t* WinT = (const bf16_t*)(wl + WL_WIN); const bf16_t* WaT = (const bf16_t*)(wl + WL_WA); const bf16_t* WbT = (const bf16_t*)(wl + WL_WB);
        const bf16_t* WcT = (const bf16_t*)(wl + WL_WC); const bf16_t* WgluT = (const bf16_t*)(wl + WL_WGLU); const bf16_t* WoutT = (const bf16_t*)(wl + WL_WOUT);
        const bf16_t* WupT = (const bf16_t*)(wl + WL_WUP); const bf16_t* WdownT = (const bf16_t*)(wl + WL_WDOWN);
        for (int b = 0; b < NB; ++b) {
            const float* xin = (l == 0) ? p.in[0] + (size_t)b * S * D : p.out + (size_t)b * S * D;
            float* xres = p.out + (size_t)b * S * D;
            const int itn = l * NB + b;
            bf16_t* H = (itn & 1) ? H1 : H0; bf16_t* Hn = (itn & 1) ? H0 : H1;
            TSTART(1)
            if (itn == 0) { rmsnorm_bf16(xin, p.in[2] + l * D, H, S, wv, 0, (int)gridDim.x); xcd_barrier(xb, wv); }
            TEND(1)
            TSTART(2)
            { EpiP E; E.P = P; E.ct = CT + (size_t)b * S * 8; E.st = ST + (size_t)b * S * 8; E.col0 = 0; run_gemm(shm, wv, H, WinT, S, NINP - 256, D, E); }
            xcd_barrier(xb, wv);
            TEND(2)
            TSTART(3)
            {
                PHASE_IDS
                TSTART(15)
                const float* cw = p.in[4] + l * 3 * 512;
                const bool heavy = (wid == 0) | (wid == 2) | (wid == 5) | (wid == 7);
                const int hq = (wid == 0) ? 0 : (wid == 2) ? 1 : (wid == 5) ? 2 : 3, lq = (wid == 1) ? 0 : (wid == 3) ? 1 : (wid == 4) ? 2 : 3;
                if (!heavy) for (int it = (int)blockIdx.x * 256 + lq * 64 + lane; it < S * 64; it += (int)gridDim.x * 256) {
                    const int t = it >> 6, c8 = (it & 63) * 8;
                    float a[8] = {0.f, 0.f, 0.f, 0.f, 0.f, 0.f, 0.f, 0.f};
#pragma unroll
                    for (int j = 0; j < 3; ++j) { const int tt = t - 2 + j; if (tt >= 0) {
                            float xx[8], cc[8]; unpack8(*(const u32x4*)(P + (size_t)tt * NINP + C_SCX + c8), xx); unpack8(*(const u32x4*)(P + (size_t)tt * NINP + C_SCC + c8), cc);
                            const f32x4 w0 = *(const f32x4*)(cw + j * 512 + c8), w1 = *(const f32x4*)(cw + j * 512 + c8 + 4);
#pragma unroll
                            for (int i = 0; i < 4; ++i) { a[i] += w0[i] * (cc[i] * xx[i]); a[4 + i] += w1[i] * (cc[4 + i] * xx[4 + i]); } } }
                    float bb[8]; unpack8(*(const u32x4*)(P + (size_t)t * NINP + C_SCB + c8), bb);
#pragma unroll
                    for (int i = 0; i < 8; ++i) a[i] *= bb[i];
                    *(u32x4*)(YA + (size_t)t * 512 + c8) = pack8(a);
                }
                TEND(15) TSTART(16)
                if (!heavy) for (int i = (int)blockIdx.x * 4 + lq; i < 2048; i += (int)gridDim.x * 4) ssm_pass1(p, l, P, XEND, i >> 6, i & 63, lane, (bf16_t*)(shm + wid * WAVE_LDS));
                TEND(16) TSTART(17)
                for (int i = gw; i < 2048; i += nw) {
                    const int bq = i >> 3; const int task = heavy ? 2047 - (bq * 4 + hq) : bq * 4 + lq;
                    indexer_task(P, task * 4, SC + (size_t)gw * 4 * 8192, IDX, lane, shm + wid * WAVE_LDS);
                }
                TEND(17)
            }
            xcd_barrier(xb, wv);
            TEND(3)
            TSTART(4)
            {
                PHASE_IDS
                TSTART(13)
                for (int i = gw; i < 2048; i += nw) ssm_pass2(p, l, P, XEND, Z, i >> 6, i & 63, lane, (bf16_t*)(shm + wid * WAVE_LDS));
                TEND(13) TSTART(14)
                float* lg = (float*)(shm + wid * WAVE_LDS); int* ids = (int*)(shm + wid * WAVE_LDS + 16384);
                if (gridDim.x == 256) {
                    const int xq = (int)(blockIdx.x & 7) * 1024 + (int)(blockIdx.x >> 3) * 8 + wid;
                    for (int j = 0; j < 4; ++j) attn_query(P, IDX, YC, xq + 256 * j, lane, lg, ids);
                } else for (int t = gw; t < S; t += nw) attn_query(P, IDX, YC, t, lane, lg, ids);
                TEND(14)
            }
            xcd_barrier(xb, wv);
            TEND(4)
            TSTART(5)
            { EpiGlu E; E.Z = Z; E.YB = YB; run_gemm(shm, wv, Z, WgluT, S, 512, 512, E); }
            if (gridDim.x >= 96 && blockIdx.x >= 64 && blockIdx.x < 96) { EpiP E; E.P = P; E.ct = CT + (size_t)b * S * 8; E.st = ST + (size_t)b * S * 8; E.col0 = NINP - 256; run_gemm_c(shm, wv, H, WinT + (size_t)(NINP - 256) * D, S, 256, D, E, (int)blockIdx.x - 64); }
            else if (gridDim.x < 96) { EpiP E; E.P = P; E.ct = CT + (size_t)b * S * 8; E.st = ST + (size_t)b * S * 8; E.col0 = NINP - 256; run_gemm(shm, wv, H, WinT + (size_t)(NINP - 256) * D, S, 256, D, E); }
            xcd_barrier(xb, wv);
            TEND(5)
            TSTART(6)
            { EpiMerge<0> E; E.G = P + C_GA; E.MF = MF; E.MB = MB; run_gemm(shm, wv, YA, WaT, S, D, 512, E); }
            { EpiMerge<1> E; E.G = P + C_GC; E.MF = MF; E.MB = MB; run_gemm(shm, wv, YC, WcT, S, D, 1024, E); }
            { EpiMerge<2> E; E.G = P + C_GB; E.MF = MF; E.MB = MB; run_gemm(shm, wv, YB, WbT, S, D, 512, E); }
            xcd_barrier(xb, wv);
            TEND(6)
            TSTART(7)
            { EpiResid E; E.res = xin; E.out = xres; run_gemm(shm, wv, MB, WoutT, S, D, D, E); }
            xcd_barrier(xb, wv);
            TEND(7)
            TSTART(8)
            rmsnorm_bf16(xres, p.in[18] + l * D, H, S, wv, 0, (int)gridDim.x);
            xcd_barrier(xb, wv);
            TEND(8)
            TSTART(9)
            { EpiStore E; E.O = UP; E.ldc = DFF2; run_gemm(shm, wv, H, WupT, S, DFF2, D, E); }
            if (itn != 2 * NB - 1) {
                const int ln_ = (b == NB - 1) ? l + 1 : l, bn_ = (b == NB - 1) ? 0 : b + 1;
                const float* xnext = (ln_ == 0) ? p.in[0] + (size_t)bn_ * S * D : p.out + (size_t)bn_ * S * D;
                if (gridDim.x == 256) { if (blockIdx.x >= 128) rmsnorm_bf16(xnext, p.in[2] + ln_ * D, Hn, S, wv, 128, 128); }
                else rmsnorm_bf16(xnext, p.in[2] + ln_ * D, Hn, S, wv, 0, (int)gridDim.x);
            }
            xcd_barrier(xb, wv);
            TEND(9)
            TSTART(10)
            {
                PHASE_IDS
                const float* fw = p.in[20] + (size_t)l * 3 * DFF2;
                const int nitem = 704 * (S / 8), nfull_trips = nitem / nthr, rem = nitem - nfull_trips * nthr;
                const bool split = (2 * rem == nthr);
                const int ntrip = split ? nfull_trips + 1 : (nitem + nthr - 1) / nthr;
                for (int trip = 0; trip < ntrip; ++trip) {
                    const bool half = split && (trip == nfull_trips);
                    const int it = half ? nfull_trips * nthr + (gt >> 1) : trip * nthr + gt;
                    if (it >= nitem) break;
                    const int ntok = half ? 4 : 8;
                    const int tc = it / 704, c8 = (it - tc * 704) * 8, t0 = tc * 8 + (half ? 4 * (gt & 1) : 0);
                    u32x4 rg[10], ru[10];
#pragma unroll
                    for (int j = 0; j < 10; ++j) { const int tt = t0 - 2 + j;
                        if (tt >= 0 && j < ntok + 2) { rg[j] = *(const u32x4*)(UP + (size_t)tt * DFF2 + c8); ru[j] = *(const u32x4*)(UP + (size_t)tt * DFF2 + DFF + c8); }
                        else { rg[j] = (u32x4){0u, 0u, 0u, 0u}; ru[j] = (u32x4){0u, 0u, 0u, 0u}; } }
                    float wg[3][8], wu[3][8];
#pragma unroll
                    for (int j = 0; j < 3; ++j) { const f32x4 g0 = *(const f32x4*)(fw + j * DFF2 + c8), g1 = *(const f32x4*)(fw + j * DFF2 + c8 + 4);
                        const f32x4 u0 = *(const f32x4*)(fw + j * DFF2 + DFF + c8), u1 = *(const f32x4*)(fw + j * DFF2 + DFF + c8 + 4);
#pragma unroll
                        for (int i = 0; i < 4; ++i) { wg[j][i] = g0[i]; wg[j][4 + i] = g1[i]; wu[j][i] = u0[i]; wu[j][4 + i] = u1[i]; } }
#pragma unroll
                    for (int r = 0; r < 8; ++r) { if (r < ntok) {
                        float G[8] = {0.f, 0.f, 0.f, 0.f, 0.f, 0.f, 0.f, 0.f}, U[8] = {0.f, 0.f, 0.f, 0.f, 0.f, 0.f, 0.f, 0.f};
#pragma unroll
                        for (int j = 0; j < 3; ++j) { float gg[8], uu[8]; unpack8(rg[r + j], gg); unpack8(ru[r + j], uu);
#pragma unroll
                            for (int i = 0; i < 8; ++i) { G[i] += wg[j][i] * gg[i]; U[i] += wu[j][i] * uu[i]; } }
                        float o[8];
#pragma unroll
                        for (int i = 0; i < 8; ++i) o[i] = G[i] * sigmoidf_(G[i]) * U[i];
                        *(u32x4*)(ACT + (size_t)(t0 + r) * DFF + c8) = pack8(o);
                    } }
                }
            }
            xcd_barrier(xb, wv);
            TEND(10)
            TSTART(11)
            { EpiResid E; E.res = xres; E.out = xres; run_gemm(shm, wv, ACT, WdownT, S, D, DFF, E); }
            xcd_barrier(xb, wv);
            TEND(11)
        }
    }
    TSTART(12)
    rmsnorm_f32_inplace(p.out, p.in[22], NB * S, wv);
    if (PROBE_PHASE >= 0) { xcd_barrier(xb, wv); TEND(12) if (blockIdx.x == 0 && opaque_tid(wv) == 256) p.out[0] = (float)tacc * 1e-3f; }
}

extern "C" void kernel_launch(void* const* d_in, const int* in_sizes, int n_in, void* d_out, int out_size, void* d_ws, size_t ws_size, hipStream_t stream) {
    static int grid_blocks = 0;
    if (!grid_blocks) {
        if (n_in != 23 || ws_size < WS_END) { fprintf(stderr, "kernel_launch: unexpected n_in %d or ws_size %zu < %zu\n", n_in, ws_size, (size_t)WS_END); grid_blocks = -1; return; }
        int dev = 0, cus = 0, per_cu = 0;
        hipGetDevice(&dev);
        hipDeviceGetAttribute(&cus, hipDeviceAttributeMultiprocessorCount, dev);
        if (hipFuncSetAttribute((const void*)fwd_megakernel, hipFuncAttributeMaxDynamicSharedMemorySize, LDS_BYTES) != hipSuccess) fprintf(stderr, "kernel_launch: hipFuncSetAttribute failed\n");
        if (hipOccupancyMaxActiveBlocksPerMultiprocessor(&per_cu, (const void*)fwd_megakernel, 512, LDS_BYTES) != hipSuccess || per_cu < 1) { per_cu = 1; (void)hipGetLastError(); }
        grid_blocks = cus * per_cu;
        if (grid_blocks > 256) grid_blocks = 256;
    }
    if (grid_blocks < 0) return;
    Params p{};
    for (int i = 0; i < 23; ++i) p.in[i] = (const float*)d_in[i];
    p.out = (float*)d_out; p.ws = (unsigned char*)d_ws;
    for (int i = 0; i < 8; ++i) p.inv_freq[i] = (float)pow(500000.0, -(double)(2 * i) / 16.0);
    (void)hipMemsetAsync((unsigned char*)d_ws + WS_BAR, 0, 16384, stream);
    void* args[] = {&p};
    hipError_t e = hipLaunchCooperativeKernel((const void*)fwd_megakernel, dim3(grid_blocks), dim3(512), args, LDS_BYTES, stream);
    if (e != hipSuccess) fprintf(stderr, "cooperative launch failed: %s (grid %d)\n", hipGetErrorString(e), grid_blocks);
}
```
